# Optimizing an MI355X kernel written in HIP

```python
import math
import jax, jax.numpy as jnp
from jax import lax
import numpy as np

D_MODEL = 2048
BATCH = 1
SEQ = 16384
DEPTH = 2

N_MIXERS = 2
N_DIFF_LAYERS = (DEPTH + 1) // 2
N_MLA_LAYERS = DEPTH // 2

DIFF_HEAD_DIM = 128
DIFF_V_DIM = 2 * DIFF_HEAD_DIM
DIFF_HEADS = D_MODEL // DIFF_V_DIM
DIFF_QK_WIDTH = 2 * DIFF_HEADS * DIFF_HEAD_DIM
DIFF_QKV_WIDTH = 2 * DIFF_QK_WIDTH + DIFF_HEADS * DIFF_V_DIM

MLA_HEADS = D_MODEL // 128
MLA_Q_LORA = 512
MLA_KV_LORA = 512
MLA_NOPE_DIM = 128
MLA_ROPE_DIM = 64
MLA_V_DIM = 128
MLA_DOWN_WIDTH = MLA_Q_LORA + MLA_KV_LORA + MLA_ROPE_DIM
ROPE_THETA = 10000.0

def _round_up(n, m):
    return ((n + m - 1) // m) * m
FFN_HIDDEN = _round_up(-(-8 * D_MODEL // 3), 256)

Q_BLOCK = 128
EPS = 1e-6

kernel_name = "hybrid_diffattn_mla_swiglu_sandwich"


def _rmsnorm(x, g):
    xf = x.astype(jnp.float32)
    y = xf * lax.rsqrt(jnp.mean(xf * xf, axis=-1, keepdims=True) + EPS)
    return (y * g.astype(jnp.float32)).astype(x.dtype)


def _seq_blocks(t):
    b, h, s, d = t.shape
    return t.reshape(b, h, s // Q_BLOCK, Q_BLOCK, d).transpose(2, 0, 1, 3, 4)


def _unblock(o):
    nb, b, h, qb, d = o.shape
    return o.transpose(1, 2, 0, 3, 4).reshape(b, h, nb * qb, d)


def _pos_blocks(positions):
    b, s = positions.shape
    return positions.reshape(b, s // Q_BLOCK, Q_BLOCK).transpose(1, 0, 2)


def _causal_mask(blk, s):
    q_idx = blk * Q_BLOCK + jnp.arange(Q_BLOCK)
    k_idx = jnp.arange(s)
    return k_idx[None, :] <= q_idx[:, None]


def _masked_softmax(scores, causal):
    return jax.nn.softmax(jnp.where(causal, scores, -jnp.inf), axis=-1)


def _alibi_slopes(n_heads):
    return jnp.exp2(-8.0 * jnp.arange(1, n_heads + 1, dtype=jnp.float32) / n_heads)


def _rope_tables(positions, dim):
    inv_freq = ROPE_THETA ** (-jnp.arange(0, dim, 2, dtype=jnp.float32) / dim)
    ang = positions.astype(jnp.float32)[..., None] * inv_freq
    return jnp.cos(ang), jnp.sin(ang)


def _apply_rope(x, cos, sin):
    x1, x2 = jnp.split(x, 2, axis=-1)
    cos = cos.astype(x.dtype)
    sin = sin.astype(x.dtype)
    return jnp.concatenate([x1 * cos - x2 * sin, x2 * cos + x1 * sin], axis=-1)


def _diff_attention(h, w_qkv, lam, subln, w_o, positions, layer_idx):
    b, s, _ = h.shape
    H, dk, dv = DIFF_HEADS, DIFF_HEAD_DIM, DIFF_V_DIM
    qkv = h @ w_qkv
    q, k, v = jnp.split(qkv, [DIFF_QK_WIDTH, 2 * DIFF_QK_WIDTH], axis=-1)
    q = q.reshape(b, s, H, 2, dk).transpose(0, 2, 3, 1, 4)
    k = k.reshape(b, s, H, 2, dk).transpose(0, 2, 3, 1, 4)
    v = v.reshape(b, s, H, dv).transpose(0, 2, 1, 3)
    q1, q2 = q[:, :, 0], q[:, :, 1]
    k1, k2 = k[:, :, 0], k[:, :, 1]

    lambda_init = 0.8 - 0.6 * math.exp(-0.3 * layer_idx)
    lf = lam.astype(jnp.float32)
    lam_full = jnp.exp(jnp.sum(lf[0] * lf[1])) - jnp.exp(jnp.sum(lf[2] * lf[3])) + lambda_init
    slopes = _alibi_slopes(H)
    scale = dk ** -0.5
    pos_k = positions.astype(jnp.float32)

    def block(args):
        blk, q1b, q2b, pq = args
        dist = jnp.abs(pq.astype(jnp.float32)[:, :, None] - pos_k[:, None, :])
        bias = -slopes[None, :, None, None] * dist[:, None]
        causal = _causal_mask(blk, s)
        s1 = jnp.einsum('bhqd,bhkd->bhqk', q1b, k1).astype(jnp.float32) * scale + bias
        s2 = jnp.einsum('bhqd,bhkd->bhqk', q2b, k2).astype(jnp.float32) * scale + bias
        p = _masked_softmax(s1, causal) - lam_full * _masked_softmax(s2, causal)
        return jnp.einsum('bhqk,bhkd->bhqd', p.astype(v.dtype), v)

    nb = s // Q_BLOCK
    o = lax.map(block, (jnp.arange(nb), _seq_blocks(q1), _seq_blocks(q2), _pos_blocks(positions)))
    o = _unblock(o)
    o = _rmsnorm(o, subln) * (1.0 - lambda_init)
    o = o.transpose(0, 2, 1, 3).reshape(b, s, H * dv)
    return o @ w_o


def _mla(h, w_down, q_norm, kv_norm, w_uq, w_ukv, w_o, positions):
    b, s, _ = h.shape
    H = MLA_HEADS
    c = h @ w_down
    cq, ckv, k_rope = jnp.split(c, [MLA_Q_LORA, MLA_Q_LORA + MLA_KV_LORA], axis=-1)
    q = (_rmsnorm(cq, q_norm) @ w_uq).reshape(b, s, H, MLA_NOPE_DIM + MLA_ROPE_DIM)
    kv = (_rmsnorm(ckv, kv_norm) @ w_ukv).reshape(b, s, H, MLA_NOPE_DIM + MLA_V_DIM)
    q_nope, q_rope = jnp.split(q, [MLA_NOPE_DIM], axis=-1)
    k_nope, v = jnp.split(kv, [MLA_NOPE_DIM], axis=-1)

    cos, sin = _rope_tables(positions, MLA_ROPE_DIM)
    q_rope = _apply_rope(q_rope, cos[:, :, None], sin[:, :, None])
    k_rope = _apply_rope(k_rope, cos, sin)

    q_nope = q_nope.transpose(0, 2, 1, 3)
    q_rope = q_rope.transpose(0, 2, 1, 3)
    k_nope = k_nope.transpose(0, 2, 1, 3)
    v = v.transpose(0, 2, 1, 3)
    scale = (MLA_NOPE_DIM + MLA_ROPE_DIM) ** -0.5

    def block(args):
        blk, qnb, qrb = args
        causal = _causal_mask(blk, s)
        sc = (jnp.einsum('bhqd,bhkd->bhqk', qnb, k_nope)
              + jnp.einsum('bhqr,bkr->bhqk', qrb, k_rope)).astype(jnp.float32) * scale
        p = _masked_softmax(sc, causal)
        return jnp.einsum('bhqk,bhkd->bhqd', p.astype(v.dtype), v)

    nb = s // Q_BLOCK
    o = lax.map(block, (jnp.arange(nb), _seq_blocks(q_nope), _seq_blocks(q_rope)))
    o = _unblock(o).transpose(0, 2, 1, 3).reshape(b, s, H * MLA_V_DIM)
    return o @ w_o


def _swiglu(h, w_in, w_out):
    g, u = jnp.split(h @ w_in, [FFN_HIDDEN], axis=-1)
    return (jax.nn.silu(g) * u) @ w_out


def setup_inputs(seed: int = 0) -> dict:
    key = jax.random.key(seed)
    ks = jax.random.split(key, 16)
    f32 = jnp.float32

    def dense(k, shape, fan_in):
        return jax.random.normal(k, shape, f32) * fan_in ** -0.5

    def gain(k, shape):
        return 1.0 + 0.02 * jax.random.normal(k, shape, f32)

    x = jax.random.normal(ks[0], (BATCH, SEQ, D_MODEL), f32)
    offset = jax.random.randint(ks[1], (BATCH, 1), 0, 4096, dtype=jnp.int32)
    positions = offset + jnp.arange(SEQ, dtype=jnp.int32)[None, :]
    norm_gains = gain(ks[2], (DEPTH, 4, D_MODEL))

    diff_w_qkv = dense(ks[3], (N_DIFF_LAYERS, D_MODEL, DIFF_QKV_WIDTH), D_MODEL)
    diff_lambda = 0.1 * jax.random.normal(ks[4], (N_DIFF_LAYERS, 4, DIFF_HEAD_DIM), f32)
    diff_subln = gain(ks[5], (N_DIFF_LAYERS, DIFF_V_DIM))
    diff_w_o = dense(ks[6], (N_DIFF_LAYERS, DIFF_HEADS * DIFF_V_DIM, D_MODEL), DIFF_HEADS * DIFF_V_DIM)

    mla_w_down = dense(ks[7], (N_MLA_LAYERS, D_MODEL, MLA_DOWN_WIDTH), D_MODEL)
    mla_q_norm = gain(ks[8], (N_MLA_LAYERS, MLA_Q_LORA))
    mla_kv_norm = gain(ks[9], (N_MLA_LAYERS, MLA_KV_LORA))
    mla_w_uq = dense(ks[10], (N_MLA_LAYERS, MLA_Q_LORA, MLA_HEADS * (MLA_NOPE_DIM + MLA_ROPE_DIM)), MLA_Q_LORA)
    mla_w_ukv = dense(ks[11], (N_MLA_LAYERS, MLA_KV_LORA, MLA_HEADS * (MLA_NOPE_DIM + MLA_V_DIM)), MLA_KV_LORA)
    mla_w_o = dense(ks[12], (N_MLA_LAYERS, MLA_HEADS * MLA_V_DIM, D_MODEL), MLA_HEADS * MLA_V_DIM)

    ffn_w_in = dense(ks[13], (DEPTH, D_MODEL, 2 * FFN_HIDDEN), D_MODEL)
    ffn_w_out = dense(ks[14], (DEPTH, FFN_HIDDEN, D_MODEL), FFN_HIDDEN)

    return {"x": x, "positions": positions, "norm_gains": norm_gains,
            "diff_w_qkv": diff_w_qkv, "diff_lambda": diff_lambda, "diff_subln": diff_subln, "diff_w_o": diff_w_o,
            "mla_w_down": mla_w_down, "mla_q_norm": mla_q_norm, "mla_kv_norm": mla_kv_norm,
            "mla_w_uq": mla_w_uq, "mla_w_ukv": mla_w_ukv, "mla_w_o": mla_w_o,
            "ffn_w_in": ffn_w_in, "ffn_w_out": ffn_w_out}


def reference(x, positions, norm_gains, diff_w_qkv, diff_lambda, diff_subln, diff_w_o,
              mla_w_down, mla_q_norm, mla_kv_norm, mla_w_uq, mla_w_ukv, mla_w_o,
              ffn_w_in, ffn_w_out):
    for i in range(DEPTH):
        g = norm_gains[i]
        hm = _rmsnorm(x, g[0])
        j = i // N_MIXERS
        if i % N_MIXERS == 0:
            y = _diff_attention(hm, diff_w_qkv[j], diff_lambda[j], diff_subln[j], diff_w_o[j], positions, i)
        else:
            y = _mla(hm, mla_w_down[j], mla_q_norm[j], mla_kv_norm[j], mla_w_uq[j], mla_w_ukv[j], mla_w_o[j], positions)
        x = x + _rmsnorm(y, g[1])
        y = _swiglu(_rmsnorm(x, g[2]), ffn_w_in[i], ffn_w_out[i])
        x = x + _rmsnorm(y, g[3])
    return x
```

```cpp
#include <hip/hip_runtime.h>
#include <hip/hip_cooperative_groups.h>
#include <cstdio>
#include <cstdint>
#include <cmath>
#include <cstring>
namespace cg = cooperative_groups;

namespace pg8 {
#define PG8_LAS __attribute__((address_space(3)))
typedef unsigned short bf16_t;
typedef short bf16x8 __attribute__((ext_vector_type(8)));
typedef float f32x4 __attribute__((ext_vector_type(4)));
typedef unsigned u32x4 __attribute__((ext_vector_type(4)));
constexpr int BM = 256, BK = 64, HALF = 128, HTB = HALF * BK * 2  , STAGE_BYTES = 8 * HTB, NXCD = 8, WGM = 8;

__host__ __device__ __forceinline__ int lds_byte(int r, int c) { const int st = (r >> 4) * 2 + (c >> 5), rr = r & 15, cc = c & 31, ob = rr * 64 + cc * 2; return st * 1024 + (ob ^ (((ob >> 9) & 1) << 5)); }
__host__ __device__ __forceinline__ void stage_rc(int b, int& R, int& C) { const int st = b / 1024, sb = b % 1024, swz = sb ^ (((sb >> 9) & 1) << 5); R = (st >> 1) * 16 + swz / 64; C = (st & 1) * 32 + (swz % 64) / 2; }
__host__ __device__ __forceinline__ int perm32(int rho) { const int n = rho >> 4, i = rho & 15; return 8 * (i >> 2) + 4 * n + (i & 3); }

struct Unit { int pm, pn; };
struct Gemm { const bf16_t* A; const bf16_t* Bt; int M, N, K; };

struct StaticOrder {
    int nM, nN, nwg, G, c;
    __host__ __device__ void init(int M, int N, int G_, int c_) { nM = M / BM; nN = N / BM; nwg = nM * nN; G = G_; c = c_; }
    __host__ __device__ bool next(int i, Unit& u) const {
        const long L = (long)i * G + c; if (L >= nwg) return false;
        int wgid = (int)L; { const int q = nwg / NXCD, r = nwg % NXCD, xcd = wgid % NXCD, off = wgid / NXCD; wgid = (xcd < r ? xcd * (q + 1) : r * (q + 1) + (xcd - r) * q) + off; }
        const int nig = WGM * nN, gid = wgid / nig, fm = gid * WGM, gsz = (nM - fm) < WGM ? (nM - fm) : WGM;
        u.pm = fm + ((wgid % nig) % gsz); u.pn = (wgid % nig) / gsz; return true;
    }
    __device__ __forceinline__ void a_ready(const Unit&) const {}
    __device__ __forceinline__ void done(const Unit&) const {}
};

__device__ __forceinline__ unsigned cvt_pk_bf16(float lo, float hi) { unsigned r; asm volatile("v_cvt_pk_bf16_f32 %0, %1, %2" : "=v"(r) : "v"(lo), "v"(hi)); return r; }

struct EpiBf16 {
    static constexpr bool PERM = true, AFTER_DRAIN = false;
    bf16_t* O; int ldc;
    __device__ __forceinline__ void operator()(const f32x4 (&acc)[2][2][4][2], const Unit& u, int wr, int wc, int fr, int fq) const {
        const int row0 = u.pm * BM + wr * 64 + fr; const int col0 = u.pn * BM + wc * 32 + 8 * fq;
#pragma unroll
        for (int ai = 0; ai < 2; ++ai)
#pragma unroll
            for (int m = 0; m < 4; ++m) { bf16_t* rowp = O + (size_t)(row0 + ai * HALF + m * 16) * ldc + col0;
#pragma unroll
                for (int bj = 0; bj < 2; ++bj) { const f32x4 v0 = acc[ai][bj][m][0], v1 = acc[ai][bj][m][1];
                    u32x4 w; w.x = cvt_pk_bf16(v0[0], v0[1]); w.y = cvt_pk_bf16(v0[2], v0[3]); w.z = cvt_pk_bf16(v1[0], v1[1]); w.w = cvt_pk_bf16(v1[2], v1[3]);
                    *(u32x4*)(rowp + bj * HALF) = w; } }
    }
};
struct EpiQKV {
    static constexpr bool PERM = true, AFTER_DRAIN = false;
    bf16_t* Qh; bf16_t* Kh; bf16_t* Vh; int M;
    __device__ __forceinline__ void operator()(const f32x4 (&acc)[2][2][4][2], const Unit& u, int wr, int wc, int fr, int fq) const {
        const int row0 = u.pm * BM + wr * 64 + fr; const int part = u.pn >> 3, head = u.pn & 7;
        bf16_t* base; size_t bjs; int pitch;
        if (part < 2) { base = (part == 0 ? Qh : Kh) + (size_t)(head * 2) * M * 128; bjs = (size_t)M * 128; pitch = 128; }
        else { base = Vh + (size_t)head * M * 256; bjs = 128; pitch = 256; }
#pragma unroll
        for (int ai = 0; ai < 2; ++ai)
#pragma unroll
            for (int m = 0; m < 4; ++m) { bf16_t* rowp = base + (size_t)(row0 + ai * HALF + m * 16) * pitch + wc * 32 + 8 * fq;
#pragma unroll
                for (int bj = 0; bj < 2; ++bj) { const f32x4 v0 = acc[ai][bj][m][0], v1 = acc[ai][bj][m][1];
                    u32x4 w; w.x = cvt_pk_bf16(v0[0], v0[1]); w.y = cvt_pk_bf16(v0[2], v0[3]); w.z = cvt_pk_bf16(v1[0], v1[1]); w.w = cvt_pk_bf16(v1[2], v1[3]);
                    *(u32x4*)(rowp + bj * bjs) = w; } }
    }
};
struct EpiF32 {
    static constexpr bool PERM = false, AFTER_DRAIN = false;
    float* O; int ldc;
    __device__ __forceinline__ void operator()(const f32x4 (&acc)[2][2][4][2], const Unit& u, int wr, int wc, int fr, int fq) const {
        const int row0 = u.pm * BM + wr * 64 + fr; const int col0 = u.pn * BM + wc * 32 + 4 * fq;
#pragma unroll
        for (int ai = 0; ai < 2; ++ai)
#pragma unroll
            for (int m = 0; m < 4; ++m) { float* rowp = O + (size_t)(row0 + ai * HALF + m * 16) * ldc + col0;
#pragma unroll
                for (int bj = 0; bj < 2; ++bj)
#pragma unroll
                    for (int n = 0; n < 2; ++n) *(f32x4*)(rowp + bj * HALF + n * 16) = acc[ai][bj][m][n]; }
    }
};
__device__ __forceinline__ float silu_mul(float g, float u) { return g * u * __builtin_amdgcn_rcpf(1.0f + __builtin_amdgcn_exp2f(-1.4426950408889634f * g)); }
struct EpiSwiGLU {
    static constexpr bool PERM = true, AFTER_DRAIN = false;
    bf16_t* O; int ldc;
    __device__ __forceinline__ void operator()(const f32x4 (&acc)[2][2][4][2], const Unit& u, int wr, int wc, int fr, int fq) const {
        const int row0 = u.pm * BM + wr * 64 + fr; const int col0 = u.pn * HALF + wc * 32 + 8 * fq;
#pragma unroll
        for (int ai = 0; ai < 2; ++ai)
#pragma unroll
            for (int m = 0; m < 4; ++m) { bf16_t* rowp = O + (size_t)(row0 + ai * HALF + m * 16) * ldc + col0;
                const f32x4 g0 = acc[ai][0][m][0], g1 = acc[ai][0][m][1], u0 = acc[ai][1][m][0], u1 = acc[ai][1][m][1];
                u32x4 w; w.x = cvt_pk_bf16(silu_mul(g0[0], u0[0]), silu_mul(g0[1], u0[1])); w.y = cvt_pk_bf16(silu_mul(g0[2], u0[2]), silu_mul(g0[3], u0[3]));
                w.z = cvt_pk_bf16(silu_mul(g1[0], u1[0]), silu_mul(g1[1], u1[1])); w.w = cvt_pk_bf16(silu_mul(g1[2], u1[2]), silu_mul(g1[3], u1[3]));
                *(u32x4*)rowp = w; }
    }
};
struct EpiQRope {
    static constexpr bool PERM = true, AFTER_DRAIN = false;
    bf16_t* O; const float* cs;
    __device__ __forceinline__ void operator()(const f32x4 (&acc)[2][2][4][2], const Unit& u, int wr, int wc, int fr, int fq) const {
        const int row0 = u.pm * BM + wr * 64 + fr;
        if (u.pn < 8) {
#pragma unroll
            for (int ai = 0; ai < 2; ++ai)
#pragma unroll
                for (int m = 0; m < 4; ++m) { bf16_t* rowp = O + (size_t)(row0 + ai * HALF + m * 16) * 3072 + wc * 32 + 8 * fq;
#pragma unroll
                    for (int bj = 0; bj < 2; ++bj) { const f32x4 v0 = acc[ai][bj][m][0], v1 = acc[ai][bj][m][1];
                        u32x4 w; w.x = cvt_pk_bf16(v0[0], v0[1]); w.y = cvt_pk_bf16(v0[2], v0[3]); w.z = cvt_pk_bf16(v1[0], v1[1]); w.w = cvt_pk_bf16(v1[2], v1[3]);
                        *(u32x4*)(rowp + (2 * u.pn + bj) * 192) = w; } }
        } else {
            const int head = 4 * (u.pn - 8) + wc;
#pragma unroll
            for (int ai = 0; ai < 2; ++ai)
#pragma unroll
                for (int m = 0; m < 4; ++m) { const int row = row0 + ai * HALF + m * 16; bf16_t* rowp = O + (size_t)row * 3072 + head * 192 + 128 + 8 * fq;
                    const float* cp = cs + (size_t)row * 64 + 8 * fq;
                    const f32x4 c0 = *(const f32x4*)cp, c1 = *(const f32x4*)(cp + 4), s0 = *(const f32x4*)(cp + 32), s1 = *(const f32x4*)(cp + 36);
                    const f32x4 a0 = acc[ai][0][m][0], a1 = acc[ai][0][m][1], b0 = acc[ai][1][m][0], b1 = acc[ai][1][m][1];
                    const f32x4 o10 = a0 * c0 - b0 * s0, o11 = a1 * c1 - b1 * s1, o20 = b0 * c0 + a0 * s0, o21 = b1 * c1 + a1 * s1;
                    u32x4 w; w.x = cvt_pk_bf16(o10[0], o10[1]); w.y = cvt_pk_bf16(o10[2], o10[3]); w.z = cvt_pk_bf16(o11[0], o11[1]); w.w = cvt_pk_bf16(o11[2], o11[3]);
                    *(u32x4*)rowp = w;
                    w.x = cvt_pk_bf16(o20[0], o20[1]); w.y = cvt_pk_bf16(o20[2], o20[3]); w.z = cvt_pk_bf16(o21[0], o21[1]); w.w = cvt_pk_bf16(o21[2], o21[3]);
                    *(u32x4*)(rowp + 32) = w; }
        }
    }
};

template <class Epi, class Sched, bool ALIGN_EPI = false, bool SP2 = false>
__device__ __forceinline__ void gemm_phase(PG8_LAS unsigned char* lds, const Gemm g, const Sched& S, const Epi& E) {
    const int tid = threadIdx.x, wid = __builtin_amdgcn_readfirstlane(tid >> 6), lane = tid & 63, wr = wid >> 2, wc = wid & 3, fr = lane & 15, fq = lane >> 4;
    const int K = g.K, nt = K / BK;
    unsigned voffA[2], voffB[2];
#pragma unroll
    for (int i = 0; i < 2; ++i) { int R, C; stage_rc(tid * 16 + i * 8192, R, C); const int Rb = Epi::PERM ? ((R & ~31) + perm32(R & 31)) : R;
        voffA[i] = (unsigned)(R * K + C) * 2u; voffB[i] = (unsigned)(Rb * K + C) * 2u; }
    const size_t kstep = (size_t)(BK * 2);
    const size_t hstep = (size_t)HALF * K * 2;
    const size_t tstep = 2 * hstep;
    const unsigned ldsw = (unsigned)wid * 1024u;
    const int aoff = lds_byte(wr * 64 + fr, fq * 8), boff = lds_byte(wc * 32 + fr, fq * 8);
#define PG8_SA(b, h) (((b) * 2 + (h)) * HTB)
#define PG8_SB(b, h) ((4 + (b) * 2 + (h)) * HTB)
#define PG8_STAGE(bufoff, gbase, voff) do { _Pragma("unroll") for (int _i = 0; _i < 2; ++_i) \
        __builtin_amdgcn_global_load_lds((const unsigned*)((const char*)(gbase) + (voff)[_i]), (PG8_LAS unsigned*)(lds + (bufoff) + ldsw + _i * 8192), 16, 0, 0); } while (0)
#define PG8_LDA(dst, b, h) do { _Pragma("unroll") for (int m = 0; m < 4; ++m) _Pragma("unroll") for (int k = 0; k < 2; ++k) dst[m][k] = *(const PG8_LAS bf16x8*)(lds + PG8_SA(b, h) + aoff + m * 2048 + k * 1024); } while (0)
#define PG8_LDB(dst, b, h) do { _Pragma("unroll") for (int n = 0; n < 2; ++n) _Pragma("unroll") for (int k = 0; k < 2; ++k) dst[n][k] = *(const PG8_LAS bf16x8*)(lds + PG8_SB(b, h) + boff + n * 2048 + k * 1024); } while (0)
#define PG8_MMA(ai, bj, At, Bt) do { __builtin_amdgcn_s_setprio(1); _Pragma("unroll") for (int m = 0; m < 4; ++m) _Pragma("unroll") for (int n = 0; n < 2; ++n) _Pragma("unroll") for (int k = 0; k < 2; ++k) \
        acc[ai][bj][m][n] = __builtin_amdgcn_mfma_f32_16x16x32_bf16(Bt[n][k], At[m][k], acc[ai][bj][m][n], 0, 0, 0); __builtin_amdgcn_s_setprio(0); } while (0)
#define PG8_WAIT_V(n) asm volatile("s_waitcnt vmcnt(" #n ")" ::: "memory")
#define PG8_WAIT_L(n) asm volatile("s_waitcnt lgkmcnt(" #n ")" ::: "memory")
#define PG8_BAR __builtin_amdgcn_s_barrier()
#define PG8_SCHED __builtin_amdgcn_sched_barrier(0)
    Unit cur, nxt; int ui = 0;
    if (!S.next(0, cur)) return;
    f32x4 acc[2][2][4][2];
#pragma unroll
    for (int a = 0; a < 2; ++a)
#pragma unroll
        for (int b = 0; b < 2; ++b)
#pragma unroll
            for (int m = 0; m < 4; ++m)
#pragma unroll
                for (int n = 0; n < 2; ++n) acc[a][b][m][n] = (f32x4){0.f, 0.f, 0.f, 0.f};
    bf16x8 At[4][2], B0[2][2], B1[2][2];
    const char* cA = (const char*)g.A + (size_t)cur.pm * tstep; const char* cB = (const char*)g.Bt + (size_t)cur.pn * tstep;
    S.a_ready(cur);
    if constexpr (SP2) {
        PG8_STAGE(PG8_SB(0, 0), cB, voffB); PG8_STAGE(PG8_SB(0, 1), cB + hstep, voffB); PG8_STAGE(PG8_SA(0, 0), cA, voffA); PG8_STAGE(PG8_SA(0, 1), cA + hstep, voffA);
        if (wr == 1) PG8_BAR;
        PG8_WAIT_V(2); PG8_BAR;
        PG8_STAGE(PG8_SB(1, 0), cB + kstep, voffB); PG8_STAGE(PG8_SA(1, 0), cA + kstep, voffA); PG8_STAGE(PG8_SB(1, 1), cB + hstep + kstep, voffB);
        PG8_WAIT_V(6); PG8_BAR;
    } else {
        PG8_STAGE(PG8_SB(0, 0), cB, voffB); PG8_STAGE(PG8_SA(0, 0), cA, voffA); PG8_STAGE(PG8_SB(0, 1), cB + hstep, voffB); PG8_STAGE(PG8_SA(0, 1), cA + hstep, voffA);
        if (wr == 1) PG8_BAR;
        PG8_WAIT_V(4); PG8_BAR;
        PG8_STAGE(PG8_SB(1, 0), cB + kstep, voffB); PG8_STAGE(PG8_SA(1, 0), cA + kstep, voffA); PG8_STAGE(PG8_SB(1, 1), cB + hstep + kstep, voffB);
        PG8_WAIT_V(6); PG8_BAR;
    }
    for (;;) {
        const bool has_next = S.next(ui + 1, nxt);
        const char* nA = has_next ? (const char*)g.A + (size_t)nxt.pm * tstep : cA; const char* nB = has_next ? (const char*)g.Bt + (size_t)nxt.pn * tstep : cB;
        for (int t = 0; t < nt; t += 2) {
            const bool last = (t == nt - 2);
            const char* a1 = cA + (size_t)(t + 1) * kstep;
            const char* a2 = last ? nA : cA + (size_t)(t + 2) * kstep; const char* b2 = last ? nB : cB + (size_t)(t + 2) * kstep;
            const char* a3 = a2 + kstep; const char* b3 = b2 + kstep;
            if (last && has_next) S.a_ready(nxt);
            if constexpr (SP2) {
            PG8_LDB(B0, 0, 0); PG8_LDB(B1, 0, 1); PG8_SCHED; PG8_LDA(At, 0, 0); PG8_STAGE(PG8_SA(1, 1), a1 + hstep, voffA);
            PG8_WAIT_V(8); PG8_WAIT_L(0); PG8_BAR; PG8_MMA(0, 0, At, B0); PG8_MMA(0, 1, At, B1); PG8_BAR; PG8_SCHED;
            PG8_LDA(At, 0, 1); PG8_STAGE(PG8_SB(0, 0), b2, voffB); PG8_STAGE(PG8_SB(0, 1), b2 + hstep, voffB); PG8_STAGE(PG8_SA(0, 0), a2, voffA);
            PG8_WAIT_V(8); PG8_WAIT_L(0); PG8_BAR; PG8_MMA(1, 0, At, B0); PG8_MMA(1, 1, At, B1); PG8_BAR; PG8_SCHED;
            PG8_LDB(B0, 1, 0); PG8_LDB(B1, 1, 1); PG8_SCHED; PG8_LDA(At, 1, 0); PG8_STAGE(PG8_SA(0, 1), a2 + hstep, voffA);
            PG8_WAIT_V(8); PG8_WAIT_L(0); PG8_BAR; PG8_MMA(0, 0, At, B0); PG8_MMA(0, 1, At, B1); PG8_BAR; PG8_SCHED;
            PG8_LDA(At, 1, 1); PG8_STAGE(PG8_SB(1, 0), b3, voffB); PG8_STAGE(PG8_SB(1, 1), b3 + hstep, voffB); PG8_STAGE(PG8_SA(1, 0), a3, voffA);
            PG8_WAIT_V(8); PG8_WAIT_L(0); PG8_BAR; PG8_MMA(1, 0, At, B0); PG8_MMA(1, 1, At, B1); PG8_BAR; PG8_SCHED;
            } else {
            PG8_LDB(B0, 0, 0); PG8_SCHED; PG8_LDA(At, 0, 0); PG8_STAGE(PG8_SA(1, 1), a1 + hstep, voffA);
            PG8_WAIT_L(8); PG8_BAR; PG8_WAIT_L(0); PG8_MMA(0, 0, At, B0); PG8_BAR; PG8_SCHED;
            PG8_LDB(B1, 0, 1); PG8_STAGE(PG8_SB(0, 0), b2, voffB);
            PG8_BAR; PG8_WAIT_L(0); PG8_MMA(0, 1, At, B1); PG8_BAR;
            PG8_LDA(At, 0, 1); PG8_STAGE(PG8_SA(0, 0), a2, voffA);
            PG8_BAR; PG8_WAIT_L(0); PG8_MMA(1, 0, At, B0); PG8_BAR; PG8_SCHED;
            PG8_STAGE(PG8_SB(0, 1), b2 + hstep, voffB);
            PG8_WAIT_V(6); PG8_BAR; PG8_MMA(1, 1, At, B1); PG8_BAR;
            PG8_LDB(B0, 1, 0); PG8_SCHED; PG8_LDA(At, 1, 0); PG8_STAGE(PG8_SA(0, 1), a2 + hstep, voffA);
            PG8_WAIT_L(8); PG8_BAR; PG8_WAIT_L(0); PG8_MMA(0, 0, At, B0); PG8_BAR; PG8_SCHED;
            PG8_LDB(B1, 1, 1); PG8_STAGE(PG8_SB(1, 0), b3, voffB);
            PG8_BAR; PG8_WAIT_L(0); PG8_MMA(0, 1, At, B1); PG8_BAR;
            PG8_LDA(At, 1, 1); PG8_STAGE(PG8_SA(1, 0), a3, voffA);
            PG8_BAR; PG8_WAIT_L(0); PG8_MMA(1, 0, At, B0); PG8_BAR; PG8_SCHED;
            PG8_STAGE(PG8_SB(1, 1), b3 + hstep, voffB);
            PG8_WAIT_V(6); PG8_BAR; PG8_MMA(1, 1, At, B1); PG8_BAR;
            }
        }
        if constexpr (ALIGN_EPI) { if (wr == 0) PG8_BAR; }
        if constexpr (!Epi::AFTER_DRAIN) { E(acc, cur, wr, wc, fr, fq); S.done(cur); }
        if (!has_next) break;
#pragma unroll
        for (int a = 0; a < 2; ++a)
#pragma unroll
            for (int b = 0; b < 2; ++b)
#pragma unroll
                for (int m = 0; m < 4; ++m)
#pragma unroll
                    for (int n = 0; n < 2; ++n) acc[a][b][m][n] = (f32x4){0.f, 0.f, 0.f, 0.f};
        cur = nxt; cA = nA; cB = nB; ++ui;
        if constexpr (ALIGN_EPI) { if (wr == 1) PG8_BAR; }
    }
    PG8_WAIT_V(0);
    if constexpr (!ALIGN_EPI) { if (wr == 0) PG8_BAR; }
    PG8_BAR;
    if constexpr (Epi::AFTER_DRAIN) { E.fused(acc, cur, wr, wc, fr, fq, lds, wid, lane); S.done(cur); }
#undef PG8_SA
#undef PG8_SB
#undef PG8_STAGE
#undef PG8_LDA
#undef PG8_LDB
#undef PG8_MMA
#undef PG8_WAIT_V
#undef PG8_WAIT_L
#undef PG8_BAR
#undef PG8_SCHED
}
}

namespace att {
#define ALAS __attribute__((address_space(3)))
typedef unsigned short bf16_t;
typedef short bf16x8 __attribute__((ext_vector_type(8)));
typedef short s16x4 __attribute__((ext_vector_type(4)));
typedef float f32x16 __attribute__((ext_vector_type(16)));
typedef float f32x4 __attribute__((ext_vector_type(4)));
typedef unsigned u32x4 __attribute__((ext_vector_type(4)));
typedef unsigned u32x2 __attribute__((ext_vector_type(2)));
__device__ __forceinline__ int crow(int r, int hi) { return (r & 3) + 8 * (r >> 2) + 4 * hi; }
__device__ __forceinline__ unsigned cvtpk(float lo, float hi) { unsigned r; asm volatile("v_cvt_pk_bf16_f32 %0, %1, %2" : "=v"(r) : "v"(lo), "v"(hi)); return r; }
__device__ __forceinline__ s16x4 vtr(const ALAS unsigned char* p) { return __builtin_bit_cast(s16x4, __builtin_amdgcn_ds_read_tr16_b64_v4i16((ALAS s16x4*)p)); }

typedef float f32x2 __attribute__((ext_vector_type(2)));
__device__ __forceinline__ float max3f(float a, float b, float c) { float r; asm("v_max3_f32 %0, %1, %2, %3" : "=v"(r) : "v"(a), "v"(b), "v"(c)); return r; }
__device__ __forceinline__ float rowmax32(const f32x16& p0, const f32x16& p1) {
    float a = max3f(p0[0], p0[1], p1[0]), b = max3f(p0[2], p0[3], p1[1]); a = max3f(a, p1[2], p1[3]);
#pragma unroll
    for (int r = 4; r < 16; r += 4) { a = max3f(a, p0[r], p0[r + 1]); b = max3f(b, p0[r + 2], p0[r + 3]); a = max3f(a, p1[r], p1[r + 1]); b = max3f(b, p1[r + 2], p1[r + 3]); }
    return max3f(a, b, b);
}
__device__ __forceinline__ float exp_sum32(f32x16& p0, f32x16& p1, float c1, float nm) {
    f32x2 acc = {0.f, 0.f};
#pragma unroll
    for (int r = 0; r < 16; r += 2) {
        f32x2 a = (f32x2){p0[r], p0[r + 1]} * c1 + nm, b = (f32x2){p1[r], p1[r + 1]} * c1 + nm;
        a.x = __builtin_amdgcn_exp2f(a.x); a.y = __builtin_amdgcn_exp2f(a.y); b.x = __builtin_amdgcn_exp2f(b.x); b.y = __builtin_amdgcn_exp2f(b.y);
        p0[r] = a.x; p0[r + 1] = a.y; p1[r] = b.x; p1[r + 1] = b.y; acc += a; acc += b;
    }
    return acc.x + acc.y;
}
__device__ __forceinline__ void glds16(const void* gsrc, unsigned lds_dst) { unsigned keep;
    asm volatile("s_mov_b32 %0, m0\n\ts_mov_b32 m0, %2\n\ts_nop 0\n\tglobal_load_lds_dwordx4 %1, off\n\ts_mov_b32 m0, %0" : "=&s"(keep) : "v"(gsrc), "s"(lds_dst) : "memory"); }
template <int MODE> struct Cfg;
template <> struct Cfg<0> { static constexpr int DQK = 128, DV = 128; };
template <> struct Cfg<1> { static constexpr int DQK = 192, DV = 128; };

struct Args {
    const bf16_t* Q; int qpitch;
    const bf16_t* K; int kpitch;
    const bf16_t* K2; int k2pitch;
    const bf16_t* V; int vpitch;
    const float* posf;
    float c1, slope2;
    const float* kmaxt; const float* pmaxt; const float* pmint;
};

#define ATT_WAITV(n) asm volatile("s_waitcnt vmcnt(" #n ")" ::: "memory")
template <int MODE>
__device__ __forceinline__ float attn_run(ALAS unsigned char* lds, const Args& A, int q0, f32x16 (&o)[Cfg<MODE>::DV / 32]) {
    constexpr int DQK = Cfg<MODE>::DQK, DV = Cfg<MODE>::DV, NKB = DQK / 64, NDB = DV / 32, NSTEP = DQK / 16;
    constexpr int KBYTES = 64 * DQK * 2, VBYTES = 64 * DV * 2, KOFF = 0, VOFF = 2 * KBYTES, POSOFF = 2 * KBYTES + 3 * VBYTES;
    constexpr int VBATCH = VBYTES / 8192;
    static_assert(POSOFF + 512 <= 131072 + 2048, "attention LDS");
    const int tid = threadIdx.x, lane = tid & 63, r32 = lane & 31, hi = lane >> 5; const int wid = __builtin_amdgcn_readfirstlane(tid >> 6);
    const int grp = wid >> 2;
    const int qrow0 = q0 + 32 * wid, qidx = qrow0 + r32;
    const int NT = (q0 + 256) / 64;
    bf16x8 qr[NSTEP];
    { const bf16_t* qp = A.Q + (size_t)qidx * A.qpitch + 8 * hi;
#pragma unroll
      for (int s = 0; s < NSTEP; ++s) qr[s] = *(const bf16x8*)(qp + 16 * s); }
    const float pqf = (MODE == 0) ? A.posf[qidx] : 0.f;
    const int krow_ = tid >> 3, kch_ = (tid & 7) ^ ((krow_ >> 1) & 7);
    const unsigned kofs = (unsigned)(krow_ * A.kpitch + kch_ * 8) * 2u;
    const unsigned k2ofs = (MODE == 1) ? (unsigned)(krow_ * A.k2pitch + kch_ * 8) * 2u : 0u;
    const unsigned vofs = (unsigned)((((tid >> 5) / NDB) * 8 + ((tid >> 2) & 7)) * A.vpitch + ((tid >> 5) % NDB) * 32 + (tid & 3) * 8) * 2u;
    auto issueK = [&](int t, int) {
        const unsigned dst = (unsigned)__builtin_amdgcn_readfirstlane((int)(unsigned)(uintptr_t)(lds + KOFF + (t & 1) * KBYTES + wid * 1024));
        const char* kb0 = (const char*)(A.K + (size_t)t * 64 * A.kpitch) + kofs;
        glds16(kb0, dst); glds16(kb0 + 128, dst + 8192);
        if (MODE == 1) glds16((const char*)(A.K2 + (size_t)t * 64 * A.k2pitch) + k2ofs, dst + 16384);
        if (MODE == 0) { if (lane < 16) glds16(A.posf + t * 64 + lane * 4, (unsigned)__builtin_amdgcn_readfirstlane((int)(unsigned)(uintptr_t)(lds + POSOFF + (t & 1) * 256))); }
    };
    auto issueV = [&](int t, int) {
        const unsigned dst = (unsigned)__builtin_amdgcn_readfirstlane((int)(unsigned)(uintptr_t)(lds + VOFF + (t % 3) * VBYTES + wid * 1024));
        const char* vb0 = (const char*)(A.V + (size_t)t * 64 * A.vpitch) + vofs;
#pragma unroll
        for (int rd = 0; rd < VBATCH; ++rd) glds16(vb0 + (size_t)rd * (128 / NDB) * A.vpitch * 2, dst + rd * 8192);
    };
    { int tq = tid; asm volatile("" : "+v"(tq)); issueK(0, tq); issueV(0, tq); }
#pragma unroll
    for (int db = 0; db < NDB; ++db)
#pragma unroll
        for (int r = 0; r < 16; ++r) o[db][r] = 0.f;
    float mrun = -1.0e30f, lrun = 0.f;
    const float k2 = (MODE == 0) ? A.slope2 / A.c1 : 0.f;
    bf16x8 pa[4];
#pragma unroll
    for (int i = 0; i < 4; ++i) pa[i] = (bf16x8){0, 0, 0, 0, 0, 0, 0, 0};

    auto qks = [&](int t, int tq) {
        if (64 * t > qrow0 + 31) return;
        const int lq = tq & 63, r32q = lq & 31, hiq = lq >> 5;
        const int koff = r32q * 128, kx = (r32q >> 1) & 7;
        const ALAS unsigned char* kbuf = lds + KOFF + (t & 1) * KBYTES;
        f32x16 s0, s1;
#pragma unroll
        for (int r = 0; r < 16; ++r) { s0[r] = 0.f; s1[r] = 0.f; }
        __builtin_amdgcn_s_setprio(2);
#pragma unroll
        for (int s = 0; s < NSTEP; ++s) {
            const int kb = s >> 2, ch = 2 * (s & 3) + hiq;
            const ALAS unsigned char* p = kbuf + kb * 8192 + koff + ((ch ^ kx) * 16);
            const bf16x8 k0 = *(const ALAS bf16x8*)p, k1 = *(const ALAS bf16x8*)(p + 4096);
            s0 = __builtin_amdgcn_mfma_f32_32x32x16_bf16(k0, qr[s], s0, 0, 0, 0);
            s1 = __builtin_amdgcn_mfma_f32_32x32x16_bf16(k1, qr[s], s1, 0, 0, 0);

        }
        __builtin_amdgcn_s_setprio(0);
        if (MODE == 0) {
            const ALAS float* pk = (const ALAS float*)(lds + POSOFF + (t & 1) * 256);
#pragma unroll
            for (int g = 0; g < 4; ++g) {
                const f32x4 p0 = *(const ALAS f32x4*)(pk + 8 * g + 4 * hiq), p1 = *(const ALAS f32x4*)(pk + 32 + 8 * g + 4 * hiq);
#pragma unroll
                for (int j = 0; j < 4; ++j) {
                    s0[4 * g + j] = __builtin_fmaf(-k2, __builtin_fabsf(pqf - p0[j]), s0[4 * g + j]);
                    s1[4 * g + j] = __builtin_fmaf(-k2, __builtin_fabsf(pqf - p1[j]), s1[4 * g + j]);
                }
            }
        }
        if (64 * t + 63 > qrow0) {
#pragma unroll
            for (int r = 0; r < 16; ++r) { const int kv = 64 * t + crow(r, hi); if (kv > qidx) s0[r] = -INFINITY; if (kv + 32 > qidx) s1[r] = -INFINITY; }
        }
        if (MODE == 1) asm volatile("s_nop 15\n\ts_nop 7" : "+v"(s0), "+v"(s1));
        float mx = rowmax32(s0, s1);
        { auto rr = __builtin_amdgcn_permlane32_swap(__float_as_uint(mx), __float_as_uint(mx), false, false); mx = __builtin_fmaxf(__uint_as_float(rr[0]), __uint_as_float(rr[1])); }
        if (__any(mx > mrun)) {
            const float mnew = __builtin_fmaxf(mrun, mx);
            const float alpha = __builtin_amdgcn_exp2f((mrun - mnew) * A.c1);
            mrun = mnew; lrun *= alpha;
#pragma unroll
            for (int db = 0; db < NDB; ++db)
#pragma unroll
                for (int r = 0; r < 16; ++r) o[db][r] *= alpha;
        }
        const float nm = -mrun * A.c1;
        lrun += exp_sum32(s0, s1, A.c1, nm);
        { u32x4 w;
          w.x = cvtpk(s0[0], s0[1]); w.y = cvtpk(s0[2], s0[3]); w.z = cvtpk(s0[4], s0[5]); w.w = cvtpk(s0[6], s0[7]); pa[0] = __builtin_bit_cast(bf16x8, w);
          w.x = cvtpk(s0[8], s0[9]); w.y = cvtpk(s0[10], s0[11]); w.z = cvtpk(s0[12], s0[13]); w.w = cvtpk(s0[14], s0[15]); pa[1] = __builtin_bit_cast(bf16x8, w);
          w.x = cvtpk(s1[0], s1[1]); w.y = cvtpk(s1[2], s1[3]); w.z = cvtpk(s1[4], s1[5]); w.w = cvtpk(s1[6], s1[7]); pa[2] = __builtin_bit_cast(bf16x8, w);
          w.x = cvtpk(s1[8], s1[9]); w.y = cvtpk(s1[10], s1[11]); w.z = cvtpk(s1[12], s1[13]); w.w = cvtpk(s1[14], s1[15]); pa[3] = __builtin_bit_cast(bf16x8, w); }
    };
    auto pv = [&](int t, int tq) {
        if (64 * t > qrow0 + 31) return;
        const int lq = tq & 63, hiq = lq >> 5;
        const int voff = (4 * hiq + ((lq & 15) >> 2)) * 64 + ((lq >> 4) & 1) * 32 + (lq & 3) * 8;
        const ALAS unsigned char* vbuf = lds + VOFF + (t % 3) * VBYTES;
#pragma unroll
        for (int db = 0; db < NDB; ++db) {
#pragma unroll
            for (int ks = 0; ks < 4; ++ks) {
                const ALAS unsigned char* vp = vbuf + ((2 * ks) * NDB + db) * 512 + voff;
                const s16x4 lo = vtr(vp), hh = vtr(vp + NDB * 512);
                const bf16x8 vf = (bf16x8){lo[0], lo[1], lo[2], lo[3], hh[0], hh[1], hh[2], hh[3]};
                o[db] = __builtin_amdgcn_mfma_f32_32x32x16_bf16(vf, pa[ks], o[db], 0, 0, 0);
            }

        }
    };
    if (grp == 0) {
        for (int t = 0; t <= NT; ++t) {
            ATT_WAITV(0);
            __builtin_amdgcn_s_barrier();
            asm volatile("" ::: "memory");
            int tq = tid; asm volatile("" : "+v"(tq));
            if (t + 1 < NT) { issueK(t + 1, tq); issueV(t + 1, tq); }
            if (t < NT) { qks(t, tq); pv(t, tq); }
        }
    } else {
        for (int t = 0; t <= NT; ++t) {
            ATT_WAITV(0);
            __builtin_amdgcn_s_barrier();
            asm volatile("" ::: "memory");
            int tq = tid; asm volatile("" : "+v"(tq));
            if (t + 1 < NT) { issueK(t + 1, tq); issueV(t + 1, tq); }
            if (t >= 1) pv(t - 1, tq);
            if (t < NT) qks(t, tq);
        }
    }
    asm volatile("s_waitcnt lgkmcnt(0)" ::: "memory");
    __syncthreads();
    const float lt = lrun + __shfl_xor(lrun, 32);
    return 1.0f / lt;
}

constexpr int PR_K = 0, PR_V = 32768, PR_POS = 131072, PR_P = 131072 + 512, PR_AL = PR_P + 16384, PR_FLAG = PR_AL + 1024, PR_X = PR_FLAG + 256, PR_BND = PR_X + 4096, PR_STOP = PR_BND + 3072, PR_END = PR_STOP + 64;
__device__ __forceinline__ float attn_diff_pair(ALAS unsigned char* lds, const Args& A, int q0, f32x16 (&o)[4]) {
    const int tid = threadIdx.x, lane = tid & 63, r32 = lane & 31, hi = lane >> 5; const int wid = __builtin_amdgcn_readfirstlane(tid >> 6);
    const int pw = wid & 3;
    const bool prod = wid < 4;
    const int qrow0 = q0 + 32 * pw, qidx = qrow0 + r32;
    const int NT = (q0 + 128) / 64;
    bf16x8 qr[8];
    float pqs = 0.f, qn = 0.f;
    if (prod) {
        const bf16_t* qp = A.Q + (size_t)qidx * A.qpitch + 8 * hi;
#pragma unroll
        for (int s = 0; s < 8; ++s) qr[s] = *(const bf16x8*)(qp + 16 * s);
        pqs = A.posf[qidx];
        float ssq = 0.f;
#pragma unroll
        for (int s = 0; s < 8; ++s)
#pragma unroll
            for (int j = 0; j < 8; ++j) { const float v = __uint_as_float(((unsigned)(unsigned short)qr[s][j]) << 16); ssq += v * v; }
        ssq += __shfl_xor(ssq, 32);
        qn = sqrtf(ssq) * 1.002f;
    } else {
#pragma unroll
        for (int s = 0; s < 8; ++s) qr[s] = (bf16x8){0, 0, 0, 0, 0, 0, 0, 0};
    }
    const int l0 = tid - 256;
    const unsigned kofs = (unsigned)((l0 >> 3) * A.kpitch + (((l0 & 7) ^ ((l0 >> 4) & 7)) * 8)) * 2u;
    const unsigned vofs = (unsigned)(((l0 >> 2) & 7) * A.vpitch + (l0 >> 5) * 32 + (l0 & 3) * 8) * 2u;
    auto issueKV = [&](int t, int st) {
        const char* kb = (const char*)(A.K + (size_t)t * 64 * A.kpitch) + kofs;
        const char* vbp = (const char*)(A.V + (size_t)t * 64 * A.vpitch) + vofs;
        const unsigned kdst = (unsigned)__builtin_amdgcn_readfirstlane((int)(unsigned)(uintptr_t)(lds + PR_K + (st & 1) * 16384 + (wid - 4) * 1024));
        const unsigned vdst = (unsigned)__builtin_amdgcn_readfirstlane((int)(unsigned)(uintptr_t)(lds + PR_V + (st % 3) * 32768 + (wid - 4) * 1024));
#pragma unroll
        for (int v = 0; v < 2; ++v) { const char* ksrc = kb + (size_t)v * 32 * A.kpitch * 2;
            glds16(ksrc, kdst + v * 4096); glds16(ksrc + 128, kdst + v * 4096 + 8192); }
        if (lane < 16) glds16(A.posf + t * 64 + lane * 4, (unsigned)__builtin_amdgcn_readfirstlane((int)(unsigned)(uintptr_t)(lds + PR_POS + (st & 1) * 256)));
#pragma unroll
        for (int v = 0; v < 2; ++v)
#pragma unroll
            for (int rd = 0; rd < 4; ++rd) glds16(vbp + (size_t)(v * 8 + rd * 16) * A.vpitch * 2, vdst + v * 4096 + rd * 8192);
    };
    if (!prod) issueKV(NT - 1, 0);
    ALAS float* bnd = (ALAS float*)(lds + PR_BND);
    volatile ALAS unsigned* stopw = (volatile ALAS unsigned*)(lds + PR_STOP);
    if (wid == 4) {
        f32x4 km = *((const f32x4*)A.kmaxt + lane), px = *((const f32x4*)A.pmaxt + lane), pn = *((const f32x4*)A.pmint + lane);
        km.y = __builtin_fmaxf(km.x, km.y); km.z = __builtin_fmaxf(km.y, km.z); km.w = __builtin_fmaxf(km.z, km.w);
        px.y = __builtin_fmaxf(px.x, px.y); px.z = __builtin_fmaxf(px.y, px.z); px.w = __builtin_fmaxf(px.z, px.w);
        pn.y = __builtin_fminf(pn.x, pn.y); pn.z = __builtin_fminf(pn.y, pn.z); pn.w = __builtin_fminf(pn.z, pn.w);
        float tk = km.w, tx = px.w, tn = pn.w;
#pragma unroll
        for (int d = 1; d < 64; d <<= 1) { const float a = __shfl_up(tk, d), b = __shfl_up(tx, d), c = __shfl_up(tn, d); if (lane >= d) { tk = __builtin_fmaxf(tk, a); tx = __builtin_fmaxf(tx, b); tn = __builtin_fminf(tn, c); } }
        float ek = __shfl_up(tk, 1), ex = __shfl_up(tx, 1), en = __shfl_up(tn, 1);
        if (lane == 0) { ek = 0.f; ex = -3.0e38f; en = 3.0e38f; }
#pragma unroll
        for (int j = 0; j < 4; ++j) { km[j] = __builtin_fmaxf(km[j], ek); px[j] = __builtin_fmaxf(px[j], ex); pn[j] = __builtin_fminf(pn[j], en); }
        *((ALAS f32x4*)bnd + lane) = km; *((ALAS f32x4*)(bnd + 256) + lane) = px; *((ALAS f32x4*)(bnd + 512) + lane) = pn;
        if (lane < 8) stopw[lane] = 0u;
    }
    int nsteps = NT;
    volatile ALAS unsigned* flagp = (volatile ALAS unsigned*)(lds + PR_FLAG) + pw;
    if (prod && lane == 0) *flagp = 0u;
#pragma unroll
    for (int db = 0; db < 4; ++db)
#pragma unroll
        for (int r = 0; r < 16; ++r) o[db][r] = 0.f;
    float mrun = -1.0e30f, lrun = 0.f;
    bf16x8 pa[4];
#pragma unroll
    for (int i = 0; i < 4; ++i) pa[i] = (bf16x8){0, 0, 0, 0, 0, 0, 0, 0};
    ALAS unsigned char* pslot = lds + PR_P + pw * 4096 + lane * 16;
    ALAS float* aslot = (ALAS float*)(lds + PR_AL + pw * 256) + lane;
#define ATT_FENCE() __builtin_amdgcn_sched_barrier(0)
    bf16x8 fa[4], fb[4];
    f32x16 s0, s1;
    auto ldK = [&](bf16x8 (&f)[4], int b, const ALAS unsigned char* kbuf, int koff, int kx, int hiq) {
#pragma unroll
        for (int i = 0; i < 2; ++i) { const int s = 2 * b + i, kb = s >> 2, ch = 2 * (s & 3) + hiq;
            const ALAS unsigned char* p = kbuf + kb * 8192 + koff + ((ch ^ kx) * 16);
            f[2 * i] = *(const ALAS bf16x8*)p; f[2 * i + 1] = *(const ALAS bf16x8*)(p + 4096); }
    };
    auto mmK = [&](const bf16x8 (&f)[4], int b) {
#pragma unroll
        for (int i = 0; i < 2; ++i) { const int s = 2 * b + i;
            if (s == 0) { const f32x16 z = {0.f, 0.f, 0.f, 0.f, 0.f, 0.f, 0.f, 0.f, 0.f, 0.f, 0.f, 0.f, 0.f, 0.f, 0.f, 0.f};
                s0 = __builtin_amdgcn_mfma_f32_32x32x16_bf16(f[0], qr[0], z, 0, 0, 0); s1 = __builtin_amdgcn_mfma_f32_32x32x16_bf16(f[1], qr[0], z, 0, 0, 0); }
            else {
            s0 = __builtin_amdgcn_mfma_f32_32x32x16_bf16(f[2 * i], qr[s], s0, 0, 0, 0);
            s1 = __builtin_amdgcn_mfma_f32_32x32x16_bf16(f[2 * i + 1], qr[s], s1, 0, 0, 0); } }
    };
    auto ldV = [&](bf16x8 (&f)[4], int ks, const ALAS unsigned char* vb) {
#pragma unroll
        for (int db = 0; db < 4; ++db) { const ALAS unsigned char* vp = vb + ((2 * ks) * 8 + db) * 512;
            const s16x4 lo = vtr(vp), hh = vtr(vp + 8 * 512);
            f[db] = (bf16x8){lo[0], lo[1], lo[2], lo[3], hh[0], hh[1], hh[2], hh[3]}; }
    };
    auto mmV = [&](const bf16x8 (&f)[4], int ks) {
#pragma unroll
        for (int db = 0; db < 4; ++db) o[db] = __builtin_amdgcn_mfma_f32_32x32x16_bf16(f[db], pa[ks], o[db], 0, 0, 0);
    };
    if (prod) {
        __builtin_amdgcn_s_setprio(3);
        for (int it = 0; it <= nsteps; ++it) {
            __builtin_amdgcn_s_barrier();
            asm volatile("" ::: "memory");
            if (it >= 1) { const unsigned sv = stopw[((it - 1) & 1) * 4] & stopw[((it - 1) & 1) * 4 + 1] & stopw[((it - 1) & 1) * 4 + 2] & stopw[((it - 1) & 1) * 4 + 3];
                if (__builtin_amdgcn_readfirstlane((int)sv) != 0 && it < nsteps) nsteps = it; }
            const int t = NT - 1 - it;
            int tq = tid; asm volatile("" : "+v"(tq));
            const bool act = (it < nsteps) && (64 * t <= qrow0 + 31);
            const bool actp = (it >= 1) && (64 * (t + 1) <= qrow0 + 31);
            const int lq = tq & 63, r32q = lq & 31, hiq = lq >> 5;
            const int koff = r32q * 128, kx = (r32q >> 1) & 7;
            const int voff = (4 * hiq + ((lq & 15) >> 2)) * 64 + ((lq >> 4) & 1) * 32 + (lq & 3) * 8;
            const ALAS unsigned char* kbuf = lds + PR_K + (it & 1) * 16384;
            const ALAS unsigned char* vb = lds + PR_V + ((it + 2) % 3) * 32768 + voff;
            if (act) {
                ldK(fa, 0, kbuf, koff, kx, hiq); ldK(fb, 1, kbuf, koff, kx, hiq); ATT_FENCE();
                mmK(fa, 0); ATT_FENCE(); ldK(fa, 2, kbuf, koff, kx, hiq); ATT_FENCE();
                mmK(fb, 1); ATT_FENCE(); ldK(fb, 3, kbuf, koff, kx, hiq); ATT_FENCE();
                mmK(fa, 2); ATT_FENCE();
            }
            if (actp) { ldV(fa, 0, vb); ATT_FENCE(); }
            if (act) { mmK(fb, 3); ATT_FENCE(); }
            if (actp) {
                ldV(fb, 1, vb); ATT_FENCE();
                mmV(fa, 0); ATT_FENCE(); ldV(fa, 2, vb); ATT_FENCE();
                mmV(fb, 1); ATT_FENCE(); ldV(fb, 3, vb); ATT_FENCE();
                mmV(fa, 2); ATT_FENCE(); mmV(fb, 3); ATT_FENCE();
            }
            if (act) {
                const ALAS float* pk = (const ALAS float*)(lds + PR_POS + (it & 1) * 256);
                const f32x4 pq4 = {pqs, pqs, pqs, pqs};
#pragma unroll
                for (int g = 0; g < 4; ++g) {
                    const f32x4 p0 = *(const ALAS f32x4*)(pk + 8 * g + 4 * hiq), p1 = *(const ALAS f32x4*)(pk + 32 + 8 * g + 4 * hiq);
                    const f32x4 d0 = pq4 - p0, d1 = pq4 - p1;
#pragma unroll
                    for (int j = 0; j < 4; ++j) {
                        s0[4 * g + j] = s0[4 * g + j] - __builtin_fabsf(d0[j]);
                        s1[4 * g + j] = s1[4 * g + j] - __builtin_fabsf(d1[j]);
                    }
                }
                if (64 * t + 63 > qrow0) {
#pragma unroll
                    for (int r = 0; r < 16; ++r) { const int kv = 64 * t + crow(r, hi); if (kv > qidx) s0[r] = -INFINITY; if (kv + 32 > qidx) s1[r] = -INFINITY; }
                }
                float mx = rowmax32(s0, s1);
                { auto rr = __builtin_amdgcn_permlane32_swap(__float_as_uint(mx), __float_as_uint(mx), false, false); mx = __builtin_fmaxf(__uint_as_float(rr[0]), __uint_as_float(rr[1])); }
                float alpha = 1.0f;
                if (__any(mx > mrun)) {
                    const float mnew = __builtin_fmaxf(mrun, mx);
                    alpha = __builtin_amdgcn_exp2f((mrun - mnew) * A.c1);
                    mrun = mnew; lrun *= alpha;
#pragma unroll
                    for (int db = 0; db < 4; ++db)
#pragma unroll
                        for (int r = 0; r < 16; ++r) o[db][r] *= alpha;
                }
                const float nm = -mrun * A.c1;
                lrun += exp_sum32(s0, s1, A.c1, nm);
                { u32x4 w;
                  w.x = cvtpk(s0[0], s0[1]); w.y = cvtpk(s0[2], s0[3]); w.z = cvtpk(s0[4], s0[5]); w.w = cvtpk(s0[6], s0[7]); pa[0] = __builtin_bit_cast(bf16x8, w);
                  w.x = cvtpk(s0[8], s0[9]); w.y = cvtpk(s0[10], s0[11]); w.z = cvtpk(s0[12], s0[13]); w.w = cvtpk(s0[14], s0[15]); pa[1] = __builtin_bit_cast(bf16x8, w);
                  w.x = cvtpk(s1[0], s1[1]); w.y = cvtpk(s1[2], s1[3]); w.z = cvtpk(s1[4], s1[5]); w.w = cvtpk(s1[6], s1[7]); pa[2] = __builtin_bit_cast(bf16x8, w);
                  w.x = cvtpk(s1[8], s1[9]); w.y = cvtpk(s1[10], s1[11]); w.z = cvtpk(s1[12], s1[13]); w.w = cvtpk(s1[14], s1[15]); pa[3] = __builtin_bit_cast(bf16x8, w); }
                if (actp) { while (*flagp != (unsigned)it) __builtin_amdgcn_s_sleep(1); }
                asm volatile("" ::: "memory");
#pragma unroll
                for (int ks = 0; ks < 4; ++ks) *(ALAS bf16x8*)(pslot + ks * 1024) = pa[ks];
                *aslot = alpha;
            }
            if (it < nsteps) {
                unsigned vote = 0u;
                if (act && t >= 1) {
                    const float ks = bnd[t - 1], px = bnd[256 + t - 1], pn = bnd[512 + t - 1];
                    const float ds = __builtin_fmaxf(0.f, __builtin_fmaxf(pqs - px, pn - pqs));
                    vote = __all(qn * ks - ds - mrun < -1200.0f) ? 1u : 0u;
                }
                if (lane == 0) stopw[(it & 1) * 4 + pw] = vote;
            }
            asm volatile("s_waitcnt lgkmcnt(0)" ::: "memory");
        }
        __builtin_amdgcn_s_setprio(0);
    } else {
        for (int it = 0; it <= nsteps; ++it) {
            if (it < NT) ATT_WAITV(8); else ATT_WAITV(0);
            __builtin_amdgcn_s_barrier();
            asm volatile("" ::: "memory");
            if (it >= 1) { const unsigned sv = stopw[((it - 1) & 1) * 4] & stopw[((it - 1) & 1) * 4 + 1] & stopw[((it - 1) & 1) * 4 + 2] & stopw[((it - 1) & 1) * 4 + 3];
                if (__builtin_amdgcn_readfirstlane((int)sv) != 0 && it < nsteps) nsteps = it; }
            const int t = NT - 1 - it;
            int tq = tid; asm volatile("" : "+v"(tq));
            if (it + 1 < nsteps) issueKV(t - 1, it + 1);
            const bool actp = (it >= 1) && (64 * (t + 1) <= qrow0 + 31);
            if (actp) {
                const int lq = tq & 63, hiq = lq >> 5;
                const int voff = (4 * hiq + ((lq & 15) >> 2)) * 64 + ((lq >> 4) & 1) * 32 + (lq & 3) * 8;
                const ALAS unsigned char* vb = lds + PR_V + ((it + 2) % 3) * 32768 + 4 * 512 + voff;
#pragma unroll
                for (int ks = 0; ks < 4; ++ks) pa[ks] = *(const ALAS bf16x8*)(pslot + ks * 1024);
                const float alpha = *aslot;
                asm volatile("s_waitcnt lgkmcnt(0)" ::: "memory");
                if (lane == 0) *flagp = (unsigned)it;
                asm volatile("" ::: "memory");
                ldV(fa, 0, vb); ldV(fb, 1, vb); ATT_FENCE();
                if (__any(alpha != 1.0f)) {
#pragma unroll
                    for (int db = 0; db < 4; ++db)
#pragma unroll
                        for (int r = 0; r < 16; ++r) o[db][r] *= alpha;
                }
                ATT_FENCE();
                mmV(fa, 0); ATT_FENCE(); ldV(fa, 2, vb); ATT_FENCE();
                mmV(fb, 1); ATT_FENCE(); ldV(fb, 3, vb); ATT_FENCE();
                mmV(fa, 2); ATT_FENCE(); mmV(fb, 3); ATT_FENCE();
            }
            asm volatile("s_waitcnt lgkmcnt(0)" ::: "memory");
        }
    }
    ALAS float* xs = (ALAS float*)(lds + PR_X) + pw * 64 + lane;
    float inv = 0.f;
    if (prod) { const float lt = lrun + __shfl_xor(lrun, 32); inv = 1.0f / lt; *xs = inv; }
    asm volatile("s_waitcnt vmcnt(0) lgkmcnt(0)" ::: "memory");
    __syncthreads();
    if (!prod) inv = *xs;
    return inv;
}
}

#define LAS __attribute__((address_space(3)))
typedef unsigned short bf16;
typedef float f32x4 __attribute__((ext_vector_type(4)));
typedef unsigned u32x4v __attribute__((ext_vector_type(4)));
typedef unsigned u32x2v __attribute__((ext_vector_type(2)));
constexpr int S = 16384, DM = 2048, FF = 5632;
constexpr int NTHREADS = 512, NWAVES = 8;
constexpr float EPS = 1e-6f;
constexpr int LDS_BYTES = 156672;
constexpr size_t MiB = 1u << 20;
constexpr size_t W_QKV = 0;
constexpr size_t W_DO = W_QKV + (size_t)6144 * 2048 * 2;
constexpr size_t W_DOWN = W_DO + (size_t)2048 * 2048 * 2;
constexpr size_t W_UQ = W_DOWN + (size_t)1280 * 2048 * 2;
constexpr size_t W_UKV = W_UQ + (size_t)3072 * 512 * 2;
constexpr size_t W_MO = W_UKV + (size_t)4096 * 512 * 2;
constexpr size_t W_FIN = W_MO + (size_t)2048 * 2048 * 2;
constexpr size_t W_FOUT = W_FIN + (size_t)2 * 11264 * 2048 * 2;
constexpr size_t W_END = W_FOUT + (size_t)2 * 2048 * 5632 * 2;
constexpr size_t WS_H = 192 * MiB;
constexpr size_t WS_C = 256 * MiB;
constexpr size_t WS_E = 480 * MiB;
constexpr size_t WS_G = 608 * MiB;
constexpr size_t WS_CQN = WS_G, WS_CKVN = WS_G + 16 * MiB, WS_KROPE = WS_G + 32 * MiB, WS_CS = WS_G + 34 * MiB, WS_POSF = WS_G + 38 * MiB;
constexpr size_t WS_KMAXT = WS_POSF + 640 * 1024, WS_PMAXT = WS_KMAXT + 16384, WS_PMINT = WS_PMAXT + 8192, WS_CTR = WS_PMINT + 8192;
constexpr size_t WS_BAR = WS_G + 38 * MiB + 768 * 1024;
constexpr size_t WS_END = WS_G + 39 * MiB;
static_assert(W_END <= WS_H, "weights fit");

struct Params {
    const float* x; const int* pos; const float* gains; const float* d_wqkv; const float* d_lam; const float* d_subln; const float* d_wo;
    const float* m_wdown; const float* m_qn; const float* m_kvn; const float* m_wuq; const float* m_wukv; const float* m_wo; const float* f_win; const float* f_wout;
    float* out; unsigned char* ws;
    float inv_freq[32];
    int ph_lo, ph_hi;
};

__device__ __forceinline__ unsigned f2bf(float f) { unsigned u = __builtin_bit_cast(unsigned, f); return (u + 0x7fffu + ((u >> 16) & 1u)) >> 16; }
__device__ __forceinline__ unsigned pk2(float lo, float hi) { return f2bf(lo) | (f2bf(hi) << 16); }
#define XB_TMO      128
#define XB_XCNT(j)  (256  + 64 * (j))
#define XB_XSUB(j)  (1280 + 64 * (j))
#define XB_XGEN(j)  (2304 + 64 * (j))
#define XB_TOP      3328
#define XB_TOPGEN   3392
#define XCD_BAR_WORDS 3456
#define XB_SPIN_CAP (1u << 18)

__device__ __forceinline__ unsigned xb_ld(unsigned* p)              { return __hip_atomic_load(p, __ATOMIC_RELAXED, __HIP_MEMORY_SCOPE_AGENT); }
__device__ __forceinline__ unsigned xb_add(unsigned* p, unsigned v) { return __hip_atomic_fetch_add(p, v, __ATOMIC_RELAXED, __HIP_MEMORY_SCOPE_AGENT); }
__device__ __forceinline__ unsigned xb_xcc_id() { return (unsigned)__builtin_amdgcn_s_getreg((3 << 11) | 20) & 0xFu; }
#define XB_SPIN(cond, bar) do { unsigned _sp = 0; while (cond) { __builtin_amdgcn_s_sleep(1); \
    if ((++_sp & 255u) == 0u) { if (xb_ld(&(bar)[XB_TMO])) break; if (_sp > XB_SPIN_CAP) { atomicAdd(&(bar)[XB_TMO], 1u); break; } } } } while (0)

struct XcdBarrier {
    unsigned* bar; unsigned x;
    volatile LAS unsigned* st;
};

__device__ __forceinline__ XcdBarrier xcd_barrier_post(unsigned* bar, volatile LAS unsigned* st) {
    XcdBarrier b; b.bar = bar; b.x = xb_xcc_id(); b.st = st;
    if (threadIdx.x == 0) (void)xb_add(&bar[XB_XCNT(b.x)], 1u);
    return b;
}
__device__ __forceinline__ void xcd_barrier_complete(unsigned* bar, unsigned x, unsigned& nloc, unsigned& nx) {
    const unsigned G = gridDim.x * gridDim.y * gridDim.z;
    unsigned sum, cnt, mine, sp = 0u;
    for (;;) {
        sum = 0u; cnt = 0u; mine = 0u;
#pragma unroll
        for (unsigned j = 0; j < 16; ++j) { const unsigned c = xb_ld(&bar[XB_XCNT(j)]); sum += c; cnt += (c > 0u) ? 1u : 0u; mine = (j == x) ? c : mine; }
        if (sum == G) break;
        __builtin_amdgcn_s_sleep(1);
        if ((++sp & 255u) == 0u) { if (xb_ld(&bar[XB_TMO])) break; if (sp > XB_SPIN_CAP) { atomicAdd(&bar[XB_TMO], 1u); break; } }
    }
    nloc = mine > 0u ? mine : 1u; nx = cnt > 0u ? cnt : 1u;
}

__device__ __forceinline__ void xcd_barrier(const XcdBarrier& b) {
    asm volatile("s_waitcnt vmcnt(0)" ::: "memory");
    __syncthreads();
    if (threadIdx.x == 0) {
        unsigned* bar = b.bar;
        __builtin_amdgcn_s_waitcnt(0);
        unsigned nloc = b.st[0], nx = b.st[1];
        if (nloc == 0u) { xcd_barrier_complete(bar, b.x, nloc, nx); b.st[0] = nloc; b.st[1] = nx; }
        const unsigned old = xb_add(&bar[XB_XSUB(b.x)], 1u);
        const unsigned gen = old / nloc;
        if (old + 1u == (gen + 1u) * nloc) {
            __builtin_amdgcn_fence(__ATOMIC_RELEASE, "agent");
            asm volatile("s_waitcnt vmcnt(0)" ::: "memory");
            const unsigned og = xb_add(&bar[XB_TOP], 1u);
            const unsigned tg = og / nx;
            if (og + 1u == (tg + 1u) * nx) xb_add(&bar[XB_TOPGEN], 1u);
            else XB_SPIN(xb_ld(&bar[XB_TOPGEN]) == tg, bar);
            __builtin_amdgcn_fence(__ATOMIC_ACQUIRE, "agent");
            xb_add(&bar[XB_XGEN(b.x)], 1u);
            asm volatile("s_waitcnt vmcnt(0)" ::: "memory");
        } else {
            XB_SPIN(xb_ld(&bar[XB_XGEN(b.x)]) == gen, bar);
            __builtin_amdgcn_fence(__ATOMIC_ACQUIRE, "agent");
            asm volatile("s_waitcnt vmcnt(0)" ::: "memory");
        }
    }
    __syncthreads();
}

__device__ __forceinline__ float wave_sum(float v) {
#pragma unroll
    for (int o = 1; o < 64; o <<= 1) v += __shfl_xor(v, o);
    return v;
}
__device__ __forceinline__ int dest_row(int mode, int n) {
    if (mode == 1) { const bool up = n >= FF; const int c = up ? n - FF : n; return (c >> 7) * 256 + (up ? 128 : 0) + (c & 127); }
    if (mode == 2) { const int head = n / 192, d = n % 192; if (d < 128) return head * 128 + d; const int i = d - 128; return 2048 + (head >> 2) * 256 + (i >> 5) * 128 + (head & 3) * 32 + (i & 31); }
    return n;
}
struct CvtItem { const float* W; bf16* WT; int K, N, mode, item; };
__device__ __forceinline__ void cvt_load(const CvtItem& c, int lane, f32x4 (&wv)[8]) {
    const int nblk = c.N / 32, kb = c.item / nblk, nb = c.item % nblk, k0 = 64 * kb, n0 = 32 * nb;
#pragma unroll
    for (int i = 0; i < 8; ++i) wv[i] = *(const f32x4*)(c.W + (size_t)(k0 + 8 * i + (lane >> 3)) * c.N + n0 + 4 * (lane & 7));
}
__device__ __forceinline__ void cvt_finish(const CvtItem& c, int lane, const f32x4 (&wv)[8], LAS float* scr) {
    const int nblk = c.N / 32, kb = c.item / nblk, nb = c.item % nblk, k0 = 64 * kb, n0 = 32 * nb;
#pragma unroll
    for (int i = 0; i < 8; ++i) { LAS float* d = scr + (8 * i + (lane >> 3)) * 33 + 4 * (lane & 7); d[0] = wv[i].x; d[1] = wv[i].y; d[2] = wv[i].z; d[3] = wv[i].w; }
    asm volatile("s_waitcnt lgkmcnt(0)" ::: "memory");
    const int cc = lane & 7;
#pragma unroll
    for (int j = 0; j < 4; ++j) { const int n = (lane >> 3) + 8 * j; const LAS float* s = scr + (8 * cc) * 33 + n;
        u32x4v o; o.x = pk2(s[0 * 33], s[1 * 33]); o.y = pk2(s[2 * 33], s[3 * 33]); o.z = pk2(s[4 * 33], s[5 * 33]); o.w = pk2(s[6 * 33], s[7 * 33]);
        *(u32x4v*)(c.WT + (size_t)dest_row(c.mode, n0 + n) * c.K + k0 + 8 * cc) = o; }
    asm volatile("s_waitcnt lgkmcnt(0)" ::: "memory");
}
__device__ __forceinline__ void load_row(const float* p, int lane, f32x4 (&v)[8]) {
#pragma unroll
    for (int j = 0; j < 8; ++j) v[j] = *((const f32x4*)p + 64 * j + lane);
}
__device__ __forceinline__ void load_row_bf16(const bf16* p, int lane, f32x4 (&v)[8]) {
#pragma unroll
    for (int j = 0; j < 8; ++j) { const u32x2v w = *((const u32x2v*)p + 64 * j + lane);
        v[j].x = __uint_as_float(w.x << 16); v[j].y = __uint_as_float(w.x & 0xffff0000u); v[j].z = __uint_as_float(w.y << 16); v[j].w = __uint_as_float(w.y & 0xffff0000u); }
}
__device__ __forceinline__ float sumsq_row(const f32x4 (&v)[8]) {
    float s = 0.f;
#pragma unroll
    for (int j = 0; j < 8; ++j) s += (v[j].x * v[j].x + v[j].y * v[j].y) + (v[j].z * v[j].z + v[j].w * v[j].w);
    return wave_sum(s);
}
__device__ __forceinline__ void norm_store_bf16(const f32x4 (&v)[8], const float* g, bf16* orow, int lane) {
    const float rs = 1.0f / sqrtf(sumsq_row(v) * (1.0f / DM) + EPS);
#pragma unroll
    for (int j = 0; j < 8; ++j) { const f32x4 gg = *((const f32x4*)g + 64 * j + lane); const f32x4 t = v[j] * rs * gg;
        u32x2v w; w.x = pk2(t.x, t.y); w.y = pk2(t.z, t.w); *((u32x2v*)orow + 64 * j + lane) = w; }
}
__device__ __forceinline__ void row_phase(const float* base, const bf16* y, const float* ga, const float* gb, float* xout, bf16* hbuf, int gw, int NGW, int lane) {
    for (int m = gw; m < S; m += NGW) {
        f32x4 v[8], xb[8];
        load_row_bf16(y + (size_t)m * DM, lane, v); load_row(base + (size_t)m * DM, lane, xb);
        const float rs = 1.0f / sqrtf(sumsq_row(v) * (1.0f / DM) + EPS);
#pragma unroll
        for (int j = 0; j < 8; ++j) { const f32x4 gg = *((const f32x4*)ga + 64 * j + lane); xb[j] = xb[j] + v[j] * rs * gg; *((f32x4*)(xout + (size_t)m * DM) + 64 * j + lane) = xb[j]; }
        if (gb) norm_store_bf16(xb, gb, hbuf + (size_t)m * DM, lane);
    }
}

template <class Epi>
__device__ __forceinline__ void run_gemm(LAS unsigned char* lds, const bf16* A, const bf16* Bt, int N, int K, const Epi& E) {
    pg8::Gemm g{A, Bt, S, N, K}; pg8::StaticOrder So; So.init(S, N, (int)gridDim.x, (int)blockIdx.x);
    pg8::gemm_phase<Epi, pg8::StaticOrder, true, true>(lds, g, So, E);
}

__global__ void __launch_bounds__(NTHREADS) fwd_mega(Params P) {
    extern __shared__ __attribute__((aligned(16))) unsigned char lds_raw[];
    LAS unsigned char* lds = (LAS unsigned char*)lds_raw;
    cg::grid_group grid = cg::this_grid();
    const int tid = threadIdx.x, lane = tid & 63, wave = __builtin_amdgcn_readfirstlane(tid >> 6);
    const int G = gridDim.x; const int bx = blockIdx.x; const int vcu = (G % 8 == 0) ? (bx % 8) * (G / 8) + bx / 8 : bx;
    const int gw = vcu * NWAVES + wave, NGW = G * NWAVES;
    unsigned char* ws = P.ws;
    bf16* Wqkv = (bf16*)(ws + W_QKV); bf16* Wdo = (bf16*)(ws + W_DO); bf16* Wdown = (bf16*)(ws + W_DOWN); bf16* Wuq = (bf16*)(ws + W_UQ); bf16* Wukv = (bf16*)(ws + W_UKV);
    bf16* Wmo = (bf16*)(ws + W_MO); bf16* Wfin = (bf16*)(ws + W_FIN); bf16* Wfout = (bf16*)(ws + W_FOUT);
    bf16* HB = (bf16*)(ws + WS_H); bf16* CB = (bf16*)(ws + WS_C); float* YB = (float*)(ws + WS_E); bf16* YH = (bf16*)(ws + WS_E);
    bf16* CQN = (bf16*)(ws + WS_CQN); bf16* CKVN = (bf16*)(ws + WS_CKVN); bf16* KROPE = (bf16*)(ws + WS_KROPE); float* CS = (float*)(ws + WS_CS); float* POSF = (float*)(ws + WS_POSF);
    volatile LAS unsigned* bst = (volatile LAS unsigned*)(lds + LDS_BYTES - 64);
    if (tid < 2) bst[tid] = 0u;
    __syncthreads();
    XcdBarrier xbar = xcd_barrier_post((unsigned*)(ws + WS_BAR), bst);
    const int lo = P.ph_lo, hi_ph = P.ph_hi;
#define IN(k) (lo <= (k) && (k) < hi_ph)
#define SEAM(k) do { if (IN(k) && IN((k) + 1)) xcd_barrier(xbar); } while (0)
    if (lo < 0) grid.sync();

    if (IN(0)) {
        LAS float* scr = (LAS float*)(lds + wave * 16384);
        constexpr int I_QKV = (2048 / 64) * (6144 / 32), I_DO = (2048 / 64) * (2048 / 32), I_DOWN = (2048 / 64) * (1088 / 32), I_UQ = (512 / 64) * (3072 / 32), I_UKV = (512 / 64) * (4096 / 32),
                      I_MO = I_DO, I_FIN = (2048 / 64) * (11264 / 32), I_FOUT = (5632 / 64) * (2048 / 32);
        constexpr int NITEMS = I_QKV + I_DO + I_DOWN + I_UQ + I_UKV + I_MO + 2 * I_FIN + 2 * I_FOUT;
        auto decode = [&](int it) -> CvtItem {
            int r = it;
            if (r < I_QKV) return CvtItem{P.d_wqkv, Wqkv, 2048, 6144, 0, r}; r -= I_QKV;
            if (r < I_DO) return CvtItem{P.d_wo, Wdo, 2048, 2048, 0, r}; r -= I_DO;
            if (r < I_DOWN) return CvtItem{P.m_wdown, Wdown, 2048, 1088, 0, r}; r -= I_DOWN;
            if (r < I_UQ) return CvtItem{P.m_wuq, Wuq, 512, 3072, 2, r}; r -= I_UQ;
            if (r < I_UKV) return CvtItem{P.m_wukv, Wukv, 512, 4096, 0, r}; r -= I_UKV;
            if (r < I_MO) return CvtItem{P.m_wo, Wmo, 2048, 2048, 0, r}; r -= I_MO;
            if (r < 2 * I_FIN) { const int l = r / I_FIN; return CvtItem{P.f_win + (size_t)l * 2048 * 11264, Wfin + (size_t)l * 11264 * 2048, 2048, 11264, 1, r % I_FIN}; } r -= 2 * I_FIN;
            { const int l = r / I_FOUT; return CvtItem{P.f_wout + (size_t)l * 5632 * 2048, Wfout + (size_t)l * 2048 * 5632, 5632, 2048, 0, r % I_FOUT}; }
        };
        if (gw < NITEMS) {
            f32x4 wa[8], wb[8];
            CvtItem cur = decode(gw); cvt_load(cur, lane, wa);
            for (int it = gw;;) {
                const int nx = it + NGW; const bool hn = nx < NITEMS;
                CvtItem nxt = cur;
                if (hn) { nxt = decode(nx); cvt_load(nxt, lane, wb); }
                cvt_finish(cur, lane, wa, scr);
                if (!hn) break;
#pragma unroll
                for (int i = 0; i < 8; ++i) wa[i] = wb[i];
                cur = nxt; it = nx;
            }
        }
        if (bx == 0 && tid == 0) *(unsigned*)(ws + WS_CTR) = 0u;
        for (int i = bx * NTHREADS + tid; i < (1280 - 1088) * 2048 / 8; i += G * NTHREADS) *((u32x4v*)(Wdown + (size_t)1088 * 2048) + i) = (u32x4v){0u, 0u, 0u, 0u};
        for (int i = bx * NTHREADS + tid; i < S; i += G * NTHREADS) { const float pf = (float)P.pos[i]; POSF[i] = pf;
#pragma unroll
            for (int h = 0; h < 8; ++h) POSF[(h + 1) * S + i] = pf * (11.313708498984761f * __builtin_amdgcn_exp2f(-(float)(h + 1))); }
        for (int m = gw; m < S; m += NGW) { f32x4 v[8]; load_row(P.x + (size_t)m * DM, lane, v); norm_store_bf16(v, P.gains, HB + (size_t)m * DM, lane); }
    }
    SEAM(0);
    if (IN(1)) { pg8::EpiQKV E{CB, CB + (size_t)16 * S * 128, CB + (size_t)32 * S * 128, S}; run_gemm(lds, HB, Wqkv, 6144, 2048, E);
        xcd_barrier(xbar);
        float* KMAXT = (float*)(ws + WS_KMAXT); float* PMAXT = (float*)(ws + WS_PMAXT); float* PMINT = (float*)(ws + WS_PMINT);
        const bf16* Kh = CB + (size_t)16 * S * 128;
        for (int task = gw; task < 16 * 256; task += NGW) {
            const u32x4v* kr = (const u32x4v*)(Kh + ((size_t)(task >> 8) * S + (size_t)(task & 255) * 64 + lane) * 128);
            float ssq = 0.f;
#pragma unroll
            for (int i = 0; i < 16; ++i) { const u32x4v w = kr[i];
#pragma unroll
                for (int j = 0; j < 4; ++j) { const float a = __uint_as_float(w[j] << 16), b = __uint_as_float(w[j] & 0xffff0000u); ssq += a * a + b * b; } }
#pragma unroll
            for (int o = 1; o < 64; o <<= 1) ssq = __builtin_fmaxf(ssq, __shfl_xor(ssq, o));
            if (lane == 0) KMAXT[task] = sqrtf(ssq) * 1.002f;
        }
        for (int task = gw; task < 8 * 256; task += NGW) {
            const float v = POSF[(size_t)((task >> 8) + 1) * S + (task & 255) * 64 + lane];
            float mx = v, mn = v;
#pragma unroll
            for (int o = 1; o < 64; o <<= 1) { mx = __builtin_fmaxf(mx, __shfl_xor(mx, o)); mn = __builtin_fminf(mn, __shfl_xor(mn, o)); }
            if (lane == 0) { PMAXT[task] = mx; PMINT[task] = mn; }
        }
    }
    SEAM(1);
    if (IN(2)) {
        _Float16* OX = (_Float16*)(ws + WS_E);
        const int r32 = lane & 31, hi = lane >> 5, pw = wave & 3, dvo = (wave >> 2) * 128;
        {
            unsigned* ctr = (unsigned*)(ws + WS_CTR);
            volatile LAS unsigned* ub = (volatile LAS unsigned*)(lds + att::PR_X + 2048);
            const float* KMAXT = (const float*)(ws + WS_KMAXT); const float* PMAXT = (const float*)(ws + WS_PMAXT); const float* PMINT = (const float*)(ws + WS_PMINT);
            for (;;) {
                if (tid == 0) *ub = atomicAdd(ctr, 1u);
                __syncthreads();
                const unsigned u = *ub;
                __syncthreads();
                if (u >= 2048u) break;
                const int head = 7 - (int)(u >> 8), qb = 127 - (int)((u & 255u) >> 1), sm = (int)(u & 1u), q0 = qb * 128;
                const int qidx = q0 + 32 * pw + r32;
                att::Args A; A.Q = CB + (size_t)(head * 2 + sm) * S * 128; A.qpitch = 128; A.K = CB + (size_t)16 * S * 128 + (size_t)(head * 2 + sm) * S * 128; A.kpitch = 128; A.K2 = nullptr; A.k2pitch = 0;
                A.V = CB + (size_t)32 * S * 128 + (size_t)head * S * 256; A.vpitch = 256; A.posf = POSF + (size_t)(head + 1) * S; A.c1 = 0.08838834764831845f * 1.4426950408889634f; A.slope2 = 0.f;
                A.kmaxt = KMAXT + (head * 2 + sm) * 256; A.pmaxt = PMAXT + head * 256; A.pmint = PMINT + head * 256;
                att::f32x16 o[4];
                const float inv = att::attn_diff_pair(lds, A, q0, o);
                _Float16* orow = OX + (size_t)sm * S * DM + (size_t)qidx * DM + head * 256 + dvo + 4 * hi;
#pragma unroll
                for (int db = 0; db < 4; ++db)
#pragma unroll
                    for (int g = 0; g < 4; ++g) {
                        typedef _Float16 h4 __attribute__((ext_vector_type(4)));
                        h4 w; w[0] = (_Float16)(o[db][4 * g] * inv); w[1] = (_Float16)(o[db][4 * g + 1] * inv); w[2] = (_Float16)(o[db][4 * g + 2] * inv); w[3] = (_Float16)(o[db][4 * g + 3] * inv);
                        *(h4*)(orow + 32 * db + 8 * g) = w; }
            }
        }
        xcd_barrier(xbar);
        {
            float lam_full;
            { const float* L = P.d_lam; const float a = L[lane] * L[128 + lane] + L[64 + lane] * L[192 + lane], b = L[256 + lane] * L[384 + lane] + L[320 + lane] * L[448 + lane];
              lam_full = __expf(wave_sum(a)) - __expf(wave_sum(b)) + 0.2f; }
            typedef _Float16 h4 __attribute__((ext_vector_type(4)));
            const f32x4 gg = *((const f32x4*)P.d_subln + lane);
            for (int it = gw; it < S * 8; it += NGW) {
                const size_t off = (size_t)it * 256 + lane * 4;
                const h4 a = *(const h4*)(OX + off), b = *(const h4*)(OX + (size_t)S * DM + off);
                f32x4 v; v.x = (float)a[0] - lam_full * (float)b[0]; v.y = (float)a[1] - lam_full * (float)b[1]; v.z = (float)a[2] - lam_full * (float)b[2]; v.w = (float)a[3] - lam_full * (float)b[3];
                const float ss = wave_sum((v.x * v.x + v.y * v.y) + (v.z * v.z + v.w * v.w));
                const float rs = 0.8f / sqrtf(ss * (1.0f / 256.0f) + EPS);
                u32x2v w; w.x = pk2(v.x * rs * gg.x, v.y * rs * gg.y); w.y = pk2(v.z * rs * gg.z, v.w * rs * gg.w);
                *(u32x2v*)(HB + off) = w;
            }
        }
    }
    SEAM(2);
    if (IN(3)) { pg8::EpiBf16 E{YH, DM}; run_gemm(lds, HB, Wdo, 2048, 2048, E); }
    SEAM(3);
    if (IN(4)) row_phase(P.x, YH, P.gains + 1 * DM, P.gains + 2 * DM, P.out, HB, gw, NGW, lane);
    SEAM(4);
    if (IN(5)) { pg8::EpiSwiGLU E{CB, FF}; run_gemm(lds, HB, Wfin, 11264, 2048, E); }
    SEAM(5);
    if (IN(6)) { pg8::EpiBf16 E{YH, DM}; run_gemm(lds, CB, Wfout, 2048, FF, E); }
    SEAM(6);
    if (IN(7)) row_phase(P.out, YH, P.gains + 3 * DM, P.gains + 4 * DM, P.out, HB, gw, NGW, lane);
    SEAM(7);
    if (IN(8)) { pg8::EpiF32 E{YB, 1280}; run_gemm(lds, HB, Wdown, 1280, 2048, E); }
    SEAM(8);
    if (IN(9)) {
        for (int m = gw; m < S; m += NGW) {
            const float* c = YB + (size_t)m * 1280;
#pragma unroll
            for (int part = 0; part < 2; ++part) {
                const f32x4 a = *((const f32x4*)(c + part * 512) + lane), b = *((const f32x4*)(c + part * 512) + 64 + lane);
                const float ss = wave_sum((a.x * a.x + a.y * a.y) + (a.z * a.z + a.w * a.w) + (b.x * b.x + b.y * b.y) + (b.z * b.z + b.w * b.w));
                const float rs = 1.0f / sqrtf(ss * (1.0f / 512.0f) + EPS);
                const float* gn = part == 0 ? P.m_qn : P.m_kvn; bf16* dst = (part == 0 ? CQN : CKVN) + (size_t)m * 512;
                const f32x4 ga = *((const f32x4*)gn + lane), gb = *((const f32x4*)gn + 64 + lane);
                u32x2v w; w.x = pk2(a.x * rs * ga.x, a.y * rs * ga.y); w.y = pk2(a.z * rs * ga.z, a.w * rs * ga.w); *((u32x2v*)dst + lane) = w;
                w.x = pk2(b.x * rs * gb.x, b.y * rs * gb.y); w.y = pk2(b.z * rs * gb.z, b.w * rs * gb.w); *((u32x2v*)dst + 64 + lane) = w;
            }
            if (lane < 32) {
                const float ang = POSF[m] * P.inv_freq[lane];
                const float cc = cosf(ang), sn = sinf(ang);
                const float x1 = c[1024 + lane], x2 = c[1056 + lane];
                KROPE[(size_t)m * 64 + lane] = (bf16)f2bf(x1 * cc - x2 * sn); KROPE[(size_t)m * 64 + 32 + lane] = (bf16)f2bf(x2 * cc + x1 * sn);
                CS[(size_t)m * 64 + lane] = cc; CS[(size_t)m * 64 + 32 + lane] = sn;
            }
        }
    }
    SEAM(9);
    bf16* QB2 = CB; bf16* KVB = CB + (size_t)S * 3072;
    if (IN(10)) {
        { pg8::EpiQRope E{QB2, CS}; run_gemm(lds, CQN, Wuq, 3072, 512, E); }
        { pg8::EpiBf16 E{KVB, 4096}; run_gemm(lds, CKVN, Wukv, 4096, 512, E); }
    }
    SEAM(10);
    if (IN(11)) {
        const int r32 = lane & 31, hi = lane >> 5;
        for (int pr = vcu; pr < 16 * 32; pr += G) {
            const int head = pr >> 5, sidx = pr & 31;
            for (int half = 0; half < 2; ++half) {
                const int qb = half == 0 ? 63 - sidx : sidx, q0 = qb * 256;
                const int qidx = q0 + 32 * wave + r32;
                att::Args A; A.Q = QB2 + head * 192; A.qpitch = 3072; A.K = KVB + head * 256; A.kpitch = 4096; A.K2 = KROPE; A.k2pitch = 64;
                A.V = KVB + head * 256 + 128; A.vpitch = 4096; A.posf = nullptr; A.c1 = 0.07216878364870323f * 1.4426950408889634f; A.slope2 = 0.f; A.kmaxt = nullptr; A.pmaxt = nullptr; A.pmint = nullptr;
                att::f32x16 o[4];
                const float inv = att::attn_run<1>(lds, A, q0, o);
                bf16* orow = HB + (size_t)qidx * DM + head * 128 + 4 * hi;
#pragma unroll
                for (int db = 0; db < 4; ++db)
#pragma unroll
                    for (int g = 0; g < 4; ++g) { u32x2v w; w.x = pk2(o[db][4 * g] * inv, o[db][4 * g + 1] * inv); w.y = pk2(o[db][4 * g + 2] * inv, o[db][4 * g + 3] * inv);
                        *(u32x2v*)(orow + 32 * db + 8 * g) = w; }
            }
        }
    }
    SEAM(11);
    if (IN(12)) { pg8::EpiBf16 E{YH, DM}; run_gemm(lds, HB, Wmo, 2048, 2048, E); }
    SEAM(12);
    if (IN(13)) row_phase(P.out, YH, P.gains + 5 * DM, P.gains + 6 * DM, P.out, HB, gw, NGW, lane);
    SEAM(13);
    if (IN(14)) { pg8::EpiSwiGLU E{CB, FF}; run_gemm(lds, HB, Wfin + (size_t)11264 * 2048, 11264, 2048, E); }
    SEAM(14);
    if (IN(15)) { pg8::EpiBf16 E{YH, DM}; run_gemm(lds, CB, Wfout + (size_t)2048 * 5632, 2048, FF, E); }
    SEAM(15);
    if (IN(16)) row_phase(P.out, YH, P.gains + 7 * DM, nullptr, P.out, nullptr, gw, NGW, lane);
#undef IN
#undef SEAM
}

constexpr int N_PHASES = 17;
#ifndef MK_MULTI
#define MK_MULTI 0
#endif
extern "C" void kernel_launch(void* const* d_in, const int* in_sizes, int n_in, void* d_out, int out_size, void* d_ws, size_t ws_size, hipStream_t stream) {
    static int grid = 0;
    if (grid == 0) {
        if (n_in != 15 || in_sizes[0] != S * DM || out_size != S * DM || ws_size < WS_END) { fprintf(stderr, "kernel_launch: unexpected shapes / workspace (n_in %d, in0 %d, out %d, ws %zu < %zu)\n", n_in, n_in > 0 ? in_sizes[0] : -1, out_size, ws_size, (size_t)WS_END); grid = -1; return; }
        int dev = 0, cus = 0, per_cu = 0;
        hipGetDevice(&dev); hipDeviceGetAttribute(&cus, hipDeviceAttributeMultiprocessorCount, dev);
        if (hipFuncSetAttribute((const void*)fwd_mega, hipFuncAttributeMaxDynamicSharedMemorySize, LDS_BYTES) != hipSuccess) { fprintf(stderr, "kernel_launch: hipFuncSetAttribute failed\n"); grid = -1; return; }
        if (hipOccupancyMaxActiveBlocksPerMultiprocessor(&per_cu, (const void*)fwd_mega, NTHREADS, LDS_BYTES) != hipSuccess || per_cu < 1) { fprintf(stderr, "kernel_launch: occupancy query gave %d\n", per_cu); per_cu = 1; (void)hipGetLastError(); }
        grid = cus * 1;
    }
    if (grid < 0) return;
    if (hipMemsetAsync((char*)d_ws + WS_BAR, 0, XCD_BAR_WORDS * 4, stream) != hipSuccess) { fprintf(stderr, "kernel_launch: hipMemsetAsync of the barrier words failed\n"); return; }
    Params p; memset(&p, 0, sizeof(p));
    p.x = (const float*)d_in[0]; p.pos = (const int*)d_in[1]; p.gains = (const float*)d_in[2]; p.d_wqkv = (const float*)d_in[3]; p.d_lam = (const float*)d_in[4]; p.d_subln = (const float*)d_in[5];
    p.d_wo = (const float*)d_in[6]; p.m_wdown = (const float*)d_in[7]; p.m_qn = (const float*)d_in[8]; p.m_kvn = (const float*)d_in[9]; p.m_wuq = (const float*)d_in[10]; p.m_wukv = (const float*)d_in[11];
    p.m_wo = (const float*)d_in[12]; p.f_win = (const float*)d_in[13]; p.f_wout = (const float*)d_in[14]; p.out = (float*)d_out; p.ws = (unsigned char*)d_ws;
    for (int i = 0; i < 32; ++i) p.inv_freq[i] = (float)pow(10000.0, -(double)(2 * i) / 64.0);
#if MK_MULTI
    for (int ph = 0; ph < N_PHASES; ++ph) { p.ph_lo = ph; p.ph_hi = ph + 1; void* args[] = {&p};
        hipError_t e = hipLaunchCooperativeKernel((const void*)fwd_mega, dim3(grid), dim3(NTHREADS), args, LDS_BYTES, stream);
        if (e != hipSuccess) { fprintf(stderr, "cooperative launch failed: %s\n", hipGetErrorString(e)); return; } }
#else
    p.ph_lo = 0; p.ph_hi = N_PHASES; void* args[] = {&p};
    hipError_t e = hipLaunchCooperativeKernel((const void*)fwd_mega, dim3(grid), dim3(NTHREADS), args, LDS_BYTES, stream);
    if (e != hipSuccess) fprintf(stderr, "cooperative launch failed: %s (grid %d)\n", hipGetErrorString(e), grid);
#endif
}
```

```cpp
#include <hip/hip_runtime.h>
#include <hip/hip_cooperative_groups.h>
#include <cstdio>
#include <cstdint>
#include <cmath>
#include <cstring>
namespace cg = cooperative_groups;

namespace pg8 {
#define PG8_LAS __attribute__((address_space(3)))
typedef unsigned short bf16_t;
typedef short bf16x8 __attribute__((ext_vector_type(8)));
typedef float f32x4 __attribute__((ext_vector_type(4)));
typedef unsigned u32x4 __attribute__((ext_vector_type(4)));
constexpr int BM = 256, BK = 64, HALF = 128, HTB = HALF * BK * 2  , STAGE_BYTES = 8 * HTB, NXCD = 8, WGM = 8;

__host__ __device__ __forceinline__ int lds_byte(int r, int c) { const int st = (r >> 4) * 2 + (c >> 5), rr = r & 15, cc = c & 31, ob = rr * 64 + cc * 2; return st * 1024 + (ob ^ (((ob >> 9) & 1) << 5)); }
__host__ __device__ __forceinline__ void stage_rc(int b, int& R, int& C) { const int st = b / 1024, sb = b % 1024, swz = sb ^ (((sb >> 9) & 1) << 5); R = (st >> 1) * 16 + swz / 64; C = (st & 1) * 32 + (swz % 64) / 2; }
__host__ __device__ __forceinline__ int perm32(int rho) { const int n = rho >> 4, i = rho & 15; return 8 * (i >> 2) + 4 * n + (i & 3); }

struct Unit { int pm, pn; };
struct Gemm { const bf16_t* A; const bf16_t* Bt; int M, N, K; };

struct StaticOrder {
    int nM, nN, nwg, G, c;
    __host__ __device__ void init(int M, int N, int G_, int c_) { nM = M / BM; nN = N / BM; nwg = nM * nN; G = G_; c = c_; }
    __host__ __device__ bool next(int i, Unit& u) const {
        const long L = (long)i * G + c; if (L >= nwg) return false;
        int wgid = (int)L; { const int q = nwg / NXCD, r = nwg % NXCD, xcd = wgid % NXCD, off = wgid / NXCD; wgid = (xcd < r ? xcd * (q + 1) : r * (q + 1) + (xcd - r) * q) + off; }
        const int nig = WGM * nN, gid = wgid / nig, fm = gid * WGM, gsz = (nM - fm) < WGM ? (nM - fm) : WGM;
        u.pm = fm + ((wgid % nig) % gsz); u.pn = (wgid % nig) / gsz; return true;
    }
    __device__ __forceinline__ void a_ready(const Unit&) const {}
    __device__ __forceinline__ void done(const Unit&) const {}
};

__device__ __forceinline__ unsigned cvt_pk_bf16(float lo, float hi) { unsigned r; asm volatile("v_cvt_pk_bf16_f32 %0, %1, %2" : "=v"(r) : "v"(lo), "v"(hi)); return r; }

struct EpiBf16 {
    static constexpr bool PERM = true, AFTER_DRAIN = false;
    bf16_t* O; int ldc;
    __device__ __forceinline__ void operator()(const f32x4 (&acc)[2][2][4][2], const Unit& u, int wr, int wc, int fr, int fq) const {
        const int row0 = u.pm * BM + wr * 64 + fr; const int col0 = u.pn * BM + wc * 32 + 8 * fq;
#pragma unroll
        for (int ai = 0; ai < 2; ++ai)
#pragma unroll
            for (int m = 0; m < 4; ++m) { bf16_t* rowp = O + (size_t)(row0 + ai * HALF + m * 16) * ldc + col0;
#pragma unroll
                for (int bj = 0; bj < 2; ++bj) { const f32x4 v0 = acc[ai][bj][m][0], v1 = acc[ai][bj][m][1];
                    u32x4 w; w.x = cvt_pk_bf16(v0[0], v0[1]); w.y = cvt_pk_bf16(v0[2], v0[3]); w.z = cvt_pk_bf16(v1[0], v1[1]); w.w = cvt_pk_bf16(v1[2], v1[3]);
                    *(u32x4*)(rowp + bj * HALF) = w; } }
    }
};
struct EpiQKV {
    static constexpr bool PERM = true, AFTER_DRAIN = false;
    bf16_t* Qh; bf16_t* Kh; bf16_t* Vh; int M;
    __device__ __forceinline__ void operator()(const f32x4 (&acc)[2][2][4][2], const Unit& u, int wr, int wc, int fr, int fq) const {
        const int row0 = u.pm * BM + wr * 64 + fr; const int part = u.pn >> 3, head = u.pn & 7;
        bf16_t* base; size_t bjs; int pitch;
        if (part < 2) { base = (part == 0 ? Qh : Kh) + (size_t)(head * 2) * M * 128; bjs = (size_t)M * 128; pitch = 128; }
        else { base = Vh + (size_t)head * M * 256; bjs = 128; pitch = 256; }
#pragma unroll
        for (int ai = 0; ai < 2; ++ai)
#pragma unroll
            for (int m = 0; m < 4; ++m) { bf16_t* rowp = base + (size_t)(row0 + ai * HALF + m * 16) * pitch + wc * 32 + 8 * fq;
#pragma unroll
                for (int bj = 0; bj < 2; ++bj) { const f32x4 v0 = acc[ai][bj][m][0], v1 = acc[ai][bj][m][1];
                    u32x4 w; w.x = cvt_pk_bf16(v0[0], v0[1]); w.y = cvt_pk_bf16(v0[2], v0[3]); w.z = cvt_pk_bf16(v1[0], v1[1]); w.w = cvt_pk_bf16(v1[2], v1[3]);
                    *(u32x4*)(rowp + bj * bjs) = w; } }
    }
};
struct EpiF32 {
    static constexpr bool PERM = false, AFTER_DRAIN = false;
    float* O; int ldc;
    __device__ __forceinline__ void operator()(const f32x4 (&acc)[2][2][4][2], const Unit& u, int wr, int wc, int fr, int fq) const {
        const int row0 = u.pm * BM + wr * 64 + fr; const int col0 = u.pn * BM + wc * 32 + 4 * fq;
#pragma unroll
        for (int ai = 0; ai < 2; ++ai)
#pragma unroll
            for (int m = 0; m < 4; ++m) { float* rowp = O + (size_t)(row0 + ai * HALF + m * 16) * ldc + col0;
#pragma unroll
                for (int bj = 0; bj < 2; ++bj)
#pragma unroll
                    for (int n = 0; n < 2; ++n) *(f32x4*)(rowp + bj * HALF + n * 16) = acc[ai][bj][m][n]; }
    }
};
__device__ __forceinline__ float silu_mul(float g, float u) { return g * u * __builtin_amdgcn_rcpf(1.0f + __builtin_amdgcn_exp2f(-1.4426950408889634f * g)); }
struct EpiSwiGLU {
    static constexpr bool PERM = true, AFTER_DRAIN = false;
    bf16_t* O; int ldc;
    __device__ __forceinline__ void operator()(const f32x4 (&acc)[2][2][4][2], const Unit& u, int wr, int wc, int fr, int fq) const {
        const int row0 = u.pm * BM + wr * 64 + fr; const int col0 = u.pn * HALF + wc * 32 + 8 * fq;
#pragma unroll
        for (int ai = 0; ai < 2; ++ai)
#pragma unroll
            for (int m = 0; m < 4; ++m) { bf16_t* rowp = O + (size_t)(row0 + ai * HALF + m * 16) * ldc + col0;
                const f32x4 g0 = acc[ai][0][m][0], g1 = acc[ai][0][m][1], u0 = acc[ai][1][m][0], u1 = acc[ai][1][m][1];
                u32x4 w; w.x = cvt_pk_bf16(silu_mul(g0[0], u0[0]), silu_mul(g0[1], u0[1])); w.y = cvt_pk_bf16(silu_mul(g0[2], u0[2]), silu_mul(g0[3], u0[3]));
                w.z = cvt_pk_bf16(silu_mul(g1[0], u1[0]), silu_mul(g1[1], u1[1])); w.w = cvt_pk_bf16(silu_mul(g1[2], u1[2]), silu_mul(g1[3], u1[3]));
                *(u32x4*)rowp = w; }
    }
};
struct EpiQRope {
    static constexpr bool PERM = true, AFTER_DRAIN = false;
    bf16_t* O; const float* cs;
    __device__ __forceinline__ void operator()(const f32x4 (&acc)[2][2][4][2], const Unit& u, int wr, int wc, int fr, int fq) const {
        const int row0 = u.pm * BM + wr * 64 + fr;
        if (u.pn < 8) {
#pragma unroll
            for (int ai = 0; ai < 2; ++ai)
#pragma unroll
                for (int m = 0; m < 4; ++m) { bf16_t* rowp = O + (size_t)(row0 + ai * HALF + m * 16) * 3072 + wc * 32 + 8 * fq;
#pragma unroll
                    for (int bj = 0; bj < 2; ++bj) { const f32x4 v0 = acc[ai][bj][m][0], v1 = acc[ai][bj][m][1];
                        u32x4 w; w.x = cvt_pk_bf16(v0[0], v0[1]); w.y = cvt_pk_bf16(v0[2], v0[3]); w.z = cvt_pk_bf16(v1[0], v1[1]); w.w = cvt_pk_bf16(v1[2], v1[3]);
                        *(u32x4*)(rowp + (2 * u.pn + bj) * 192) = w; } }
        } else {
            const int head = 4 * (u.pn - 8) + wc;
#pragma unroll
            for (int ai = 0; ai < 2; ++ai)
#pragma unroll
                for (int m = 0; m < 4; ++m) { const int row = row0 + ai * HALF + m * 16; bf16_t* rowp = O + (size_t)row * 3072 + head * 192 + 128 + 8 * fq;
                    const float* cp = cs + (size_t)row * 64 + 8 * fq;
                    const f32x4 c0 = *(const f32x4*)cp, c1 = *(const f32x4*)(cp + 4), s0 = *(const f32x4*)(cp + 32), s1 = *(const f32x4*)(cp + 36);
                    const f32x4 a0 = acc[ai][0][m][0], a1 = acc[ai][0][m][1], b0 = acc[ai][1][m][0], b1 = acc[ai][1][m][1];
                    const f32x4 o10 = a0 * c0 - b0 * s0, o11 = a1 * c1 - b1 * s1, o20 = b0 * c0 + a0 * s0, o21 = b1 * c1 + a1 * s1;
                    u32x4 w; w.x = cvt_pk_bf16(o10[0], o10[1]); w.y = cvt_pk_bf16(o10[2], o10[3]); w.z = cvt_pk_bf16(o11[0], o11[1]); w.w = cvt_pk_bf16(o11[2], o11[3]);
                    *(u32x4*)rowp = w;
                    w.x = cvt_pk_bf16(o20[0], o20[1]); w.y = cvt_pk_bf16(o20[2], o20[3]); w.z = cvt_pk_bf16(o21[0], o21[1]); w.w = cvt_pk_bf16(o21[2], o21[3]);
                    *(u32x4*)(rowp + 32) = w; }
        }
    }
};

template <class Epi, class Sched, bool ALIGN_EPI = false, bool SP2 = false>
__device__ __forceinline__ void gemm_phase(PG8_LAS unsigned char* lds, const Gemm g, const Sched& S, const Epi& E) {
    const int tid = threadIdx.x, wid = __builtin_amdgcn_readfirstlane(tid >> 6), lane = tid & 63, wr = wid >> 2, wc = wid & 3, fr = lane & 15, fq = lane >> 4;
    const int K = g.K, nt = K / BK;
    unsigned voffA[2], voffB[2];
#pragma unroll
    for (int i = 0; i < 2; ++i) { int R, C; stage_rc(tid * 16 + i * 8192, R, C); const int Rb = Epi::PERM ? ((R & ~31) + perm32(R & 31)) : R;
        voffA[i] = (unsigned)(R * K + C) * 2u; voffB[i] = (unsigned)(Rb * K + C) * 2u; }
    const size_t kstep = (size_t)(BK * 2);
    const size_t hstep = (size_t)HALF * K * 2;
    const size_t tstep = 2 * hstep;
    const unsigned ldsw = (unsigned)wid * 1024u;
    const int aoff = lds_byte(wr * 64 + fr, fq * 8), boff = lds_byte(wc * 32 + fr, fq * 8);
#define PG8_SA(b, h) (((b) * 2 + (h)) * HTB)
#define PG8_SB(b, h) ((4 + (b) * 2 + (h)) * HTB)
#define PG8_STAGE(bufoff, gbase, voff) do { _Pragma("unroll") for (int _i = 0; _i < 2; ++_i) \
        __builtin_amdgcn_global_load_lds((const unsigned*)((const char*)(gbase) + (voff)[_i]), (PG8_LAS unsigned*)(lds + (bufoff) + ldsw + _i * 8192), 16, 0, 0); } while (0)
#define PG8_LDA(dst, b, h) do { _Pragma("unroll") for (int m = 0; m < 4; ++m) _Pragma("unroll") for (int k = 0; k < 2; ++k) dst[m][k] = *(const PG8_LAS bf16x8*)(lds + PG8_SA(b, h) + aoff + m * 2048 + k * 1024); } while (0)
#define PG8_LDB(dst, b, h) do { _Pragma("unroll") for (int n = 0; n < 2; ++n) _Pragma("unroll") for (int k = 0; k < 2; ++k) dst[n][k] = *(const PG8_LAS bf16x8*)(lds + PG8_SB(b, h) + boff + n * 2048 + k * 1024); } while (0)
#define PG8_MMA(ai, bj, At, Bt) do { __builtin_amdgcn_s_setprio(1); _Pragma("unroll") for (int m = 0; m < 4; ++m) _Pragma("unroll") for (int n = 0; n < 2; ++n) _Pragma("unroll") for (int k = 0; k < 2; ++k) \
        acc[ai][bj][m][n] = __builtin_amdgcn_mfma_f32_16x16x32_bf16(Bt[n][k], At[m][k], acc[ai][bj][m][n], 0, 0, 0); __builtin_amdgcn_s_setprio(0); } while (0)
#define PG8_WAIT_V(n) asm volatile("s_waitcnt vmcnt(" #n ")" ::: "memory")
#define PG8_WAIT_L(n) asm volatile("s_waitcnt lgkmcnt(" #n ")" ::: "memory")
#define PG8_BAR __builtin_amdgcn_s_barrier()
#define PG8_SCHED __builtin_amdgcn_sched_barrier(0)
    Unit cur, nxt; int ui = 0;
    if (!S.next(0, cur)) return;
    f32x4 acc[2][2][4][2];
#pragma unroll
    for (int a = 0; a < 2; ++a)
#pragma unroll
        for (int b = 0; b < 2; ++b)
#pragma unroll
            for (int m = 0; m < 4; ++m)
#pragma unroll
                for (int n = 0; n < 2; ++n) acc[a][b][m][n] = (f32x4){0.f, 0.f, 0.f, 0.f};
    bf16x8 At[4][2], B0[2][2], B1[2][2];
    const char* cA = (const char*)g.A + (size_t)cur.pm * tstep; const char* cB = (const char*)g.Bt + (size_t)cur.pn * tstep;
    S.a_ready(cur);
    if constexpr (SP2) {
        PG8_STAGE(PG8_SB(0, 0), cB, voffB); PG8_STAGE(PG8_SB(0, 1), cB + hstep, voffB); PG8_STAGE(PG8_SA(0, 0), cA, voffA); PG8_STAGE(PG8_SA(0, 1), cA + hstep, voffA);
        if (wr == 1) PG8_BAR;
        PG8_WAIT_V(2); PG8_BAR;
        PG8_STAGE(PG8_SB(1, 0), cB + kstep, voffB); PG8_STAGE(PG8_SA(1, 0), cA + kstep, voffA); PG8_STAGE(PG8_SB(1, 1), cB + hstep + kstep, voffB);
        PG8_WAIT_V(6); PG8_BAR;
    } else {
        PG8_STAGE(PG8_SB(0, 0), cB, voffB); PG8_STAGE(PG8_SA(0, 0), cA, voffA); PG8_STAGE(PG8_SB(0, 1), cB + hstep, voffB); PG8_STAGE(PG8_SA(0, 1), cA + hstep, voffA);
        if (wr == 1) PG8_BAR;
        PG8_WAIT_V(4); PG8_BAR;
        PG8_STAGE(PG8_SB(1, 0), cB + kstep, voffB); PG8_STAGE(PG8_SA(1, 0), cA + kstep, voffA); PG8_STAGE(PG8_SB(1, 1), cB + hstep + kstep, voffB);
        PG8_WAIT_V(6); PG8_BAR;
    }
    for (;;) {
        const bool has_next = S.next(ui + 1, nxt);
        const char* nA = has_next ? (const char*)g.A + (size_t)nxt.pm * tstep : cA; const char* nB = has_next ? (const char*)g.Bt + (size_t)nxt.pn * tstep : cB;
        for (int t = 0; t < nt; t += 2) {
            const bool last = (t == nt - 2);
            const char* a1 = cA + (size_t)(t + 1) * kstep;
            const char* a2 = last ? nA : cA + (size_t)(t + 2) * kstep; const char* b2 = last ? nB : cB + (size_t)(t + 2) * kstep;
            const char* a3 = a2 + kstep; const char* b3 = b2 + kstep;
            if (last && has_next) S.a_ready(nxt);
            if constexpr (SP2) {
            PG8_LDB(B0, 0, 0); PG8_LDB(B1, 0, 1); PG8_SCHED; PG8_LDA(At, 0, 0); PG8_STAGE(PG8_SA(1, 1), a1 + hstep, voffA);
            PG8_WAIT_V(8); PG8_WAIT_L(0); PG8_BAR; PG8_MMA(0, 0, At, B0); PG8_MMA(0, 1, At, B1); PG8_BAR; PG8_SCHED;
            PG8_LDA(At, 0, 1); PG8_STAGE(PG8_SB(0, 0), b2, voffB); PG8_STAGE(PG8_SB(0, 1), b2 + hstep, voffB); PG8_STAGE(PG8_SA(0, 0), a2, voffA);
            PG8_WAIT_V(8); PG8_WAIT_L(0); PG8_BAR; PG8_MMA(1, 0, At, B0); PG8_MMA(1, 1, At, B1); PG8_BAR; PG8_SCHED;
            PG8_LDB(B0, 1, 0); PG8_LDB(B1, 1, 1); PG8_SCHED; PG8_LDA(At, 1, 0); PG8_STAGE(PG8_SA(0, 1), a2 + hstep, voffA);
            PG8_WAIT_V(8); PG8_WAIT_L(0); PG8_BAR; PG8_MMA(0, 0, At, B0); PG8_MMA(0, 1, At, B1); PG8_BAR; PG8_SCHED;
            PG8_LDA(At, 1, 1); PG8_STAGE(PG8_SB(1, 0), b3, voffB); PG8_STAGE(PG8_SB(1, 1), b3 + hstep, voffB); PG8_STAGE(PG8_SA(1, 0), a3, voffA);
            PG8_WAIT_V(8); PG8_WAIT_L(0); PG8_BAR; PG8_MMA(1, 0, At, B0); PG8_MMA(1, 1, At, B1); PG8_BAR; PG8_SCHED;
            } else {
            PG8_LDB(B0, 0, 0); PG8_SCHED; PG8_LDA(At, 0, 0); PG8_STAGE(PG8_SA(1, 1), a1 + hstep, voffA);
            PG8_WAIT_L(8); PG8_BAR; PG8_WAIT_L(0); PG8_MMA(0, 0, At, B0); PG8_BAR; PG8_SCHED;
            PG8_LDB(B1, 0, 1); PG8_STAGE(PG8_SB(0, 0), b2, voffB);
            PG8_BAR; PG8_WAIT_L(0); PG8_MMA(0, 1, At, B1); PG8_BAR;
            PG8_LDA(At, 0, 1); PG8_STAGE(PG8_SA(0, 0), a2, voffA);
            PG8_BAR; PG8_WAIT_L(0); PG8_MMA(1, 0, At, B0); PG8_BAR; PG8_SCHED;
            PG8_STAGE(PG8_SB(0, 1), b2 + hstep, voffB);
            PG8_WAIT_V(6); PG8_BAR; PG8_MMA(1, 1, At, B1); PG8_BAR;
            PG8_LDB(B0, 1, 0); PG8_SCHED; PG8_LDA(At, 1, 0); PG8_STAGE(PG8_SA(0, 1), a2 + hstep, voffA);
            PG8_WAIT_L(8); PG8_BAR; PG8_WAIT_L(0); PG8_MMA(0, 0, At, B0); PG8_BAR; PG8_SCHED;
            PG8_LDB(B1, 1, 1); PG8_STAGE(PG8_SB(1, 0), b3, voffB);
            PG8_BAR; PG8_WAIT_L(0); PG8_MMA(0, 1, At, B1); PG8_BAR;
            PG8_LDA(At, 1, 1); PG8_STAGE(PG8_SA(1, 0), a3, voffA);
            PG8_BAR; PG8_WAIT_L(0); PG8_MMA(1, 0, At, B0); PG8_BAR; PG8_SCHED;
            PG8_STAGE(PG8_SB(1, 1), b3 + hstep, voffB);
            PG8_WAIT_V(6); PG8_BAR; PG8_MMA(1, 1, At, B1); PG8_BAR;
            }
        }
        if constexpr (ALIGN_EPI) { if (wr == 0) PG8_BAR; }
        if constexpr (!Epi::AFTER_DRAIN) { E(acc, cur, wr, wc, fr, fq); S.done(cur); }
        if (!has_next) break;
#pragma unroll
        for (int a = 0; a < 2; ++a)
#pragma unroll
            for (int b = 0; b < 2; ++b)
#pragma unroll
                for (int m = 0; m < 4; ++m)
#pragma unroll
                    for (int n = 0; n < 2; ++n) acc[a][b][m][n] = (f32x4){0.f, 0.f, 0.f, 0.f};
        cur = nxt; cA = nA; cB = nB; ++ui;
        if constexpr (ALIGN_EPI) { if (wr == 1) PG8_BAR; }
    }
    PG8_WAIT_V(0);
    if constexpr (!ALIGN_EPI) { if (wr == 0) PG8_BAR; }
    PG8_BAR;
    if constexpr (Epi::AFTER_DRAIN) { E.fused(acc, cur, wr, wc, fr, fq, lds, wid, lane); S.done(cur); }
#undef PG8_SA
#undef PG8_SB
#undef PG8_STAGE
#undef PG8_LDA
#undef PG8_LDB
#undef PG8_MMA
#undef PG8_WAIT_V
#undef PG8_WAIT_L
#undef PG8_BAR
#undef PG8_SCHED
}
}

namespace att {
#define ALAS __attribute__((address_space(3)))
typedef unsigned short bf16_t;
typedef short bf16x8 __attribute__((ext_vector_type(8)));
typedef short s16x4 __attribute__((ext_vector_type(4)));
typedef float f32x16 __attribute__((ext_vector_type(16)));
typedef float f32x4 __attribute__((ext_vector_type(4)));
typedef unsigned u32x4 __attribute__((ext_vector_type(4)));
typedef unsigned u32x2 __attribute__((ext_vector_type(2)));
__device__ __forceinline__ int crow(int r, int hi) { return (r & 3) + 8 * (r >> 2) + 4 * hi; }
__device__ __forceinline__ unsigned cvtpk(float lo, float hi) { unsigned r; asm volatile("v_cvt_pk_bf16_f32 %0, %1, %2" : "=v"(r) : "v"(lo), "v"(hi)); return r; }
__device__ __forceinline__ s16x4 vtr(const ALAS unsigned char* p) { return __builtin_bit_cast(s16x4, __builtin_amdgcn_ds_read_tr16_b64_v4i16((ALAS s16x4*)p)); }

typedef float f32x2 __attribute__((ext_vector_type(2)));
__device__ __forceinline__ float max3f(float a, float b, float c) { float r; asm("v_max3_f32 %0, %1, %2, %3" : "=v"(r) : "v"(a), "v"(b), "v"(c)); return r; }
__device__ __forceinline__ float rowmax32(const f32x16& p0, const f32x16& p1) {
    float a = max3f(p0[0], p0[1], p1[0]), b = max3f(p0[2], p0[3], p1[1]); a = max3f(a, p1[2], p1[3]);
#pragma unroll
    for (int r = 4; r < 16; r += 4) { a = max3f(a, p0[r], p0[r + 1]); b = max3f(b, p0[r + 2], p0[r + 3]); a = max3f(a, p1[r], p1[r + 1]); b = max3f(b, p1[r + 2], p1[r + 3]); }
    return max3f(a, b, b);
}
__device__ __forceinline__ float exp_sum32(f32x16& p0, f32x16& p1, float c1, float nm) {
    f32x2 acc = {0.f, 0.f};
#pragma unroll
    for (int r = 0; r < 16; r += 2) {
        f32x2 a = (f32x2){p0[r], p0[r + 1]} * c1 + nm, b = (f32x2){p1[r], p1[r + 1]} * c1 + nm;
        a.x = __builtin_amdgcn_exp2f(a.x); a.y = __builtin_amdgcn_exp2f(a.y); b.x = __builtin_amdgcn_exp2f(b.x); b.y = __builtin_amdgcn_exp2f(b.y);
        p0[r] = a.x; p0[r + 1] = a.y; p1[r] = b.x; p1[r + 1] = b.y; acc += a; acc += b;
    }
    return acc.x + acc.y;
}
__device__ __forceinline__ void glds16(const void* gsrc, unsigned lds_dst) { unsigned keep;
    asm volatile("s_mov_b32 %0, m0\n\ts_mov_b32 m0, %2\n\ts_nop 0\n\tglobal_load_lds_dwordx4 %1, off\n\ts_mov_b32 m0, %0" : "=&s"(keep) : "v"(gsrc), "s"(lds_dst) : "memory"); }
template <int MODE> struct Cfg;
template <> struct Cfg<0> { static constexpr int DQK = 128, DV = 128; };
template <> struct Cfg<1> { static constexpr int DQK = 192, DV = 128; };

struct Args {
    const bf16_t* Q; int qpitch;
    const bf16_t* K; int kpitch;
    const bf16_t* K2; int k2pitch;
    const bf16_t* V; int vpitch;
    const float* posf;
    float c1, slope2;
    const float* kmaxt; const float* pmaxt; const float* pmint;
};

#define ATT_WAITV(n) asm volatile("s_waitcnt vmcnt(" #n ")" ::: "memory")
template <int MODE>
__device__ __forceinline__ float attn_run(ALAS unsigned char* lds, const Args& A, int q0, f32x16 (&o)[Cfg<MODE>::DV / 32]) {
    constexpr int DQK = Cfg<MODE>::DQK, DV = Cfg<MODE>::DV, NKB = DQK / 64, NDB = DV / 32, NSTEP = DQK / 16;
    constexpr int KBYTES = 64 * DQK * 2, VBYTES = 64 * DV * 2, KOFF = 0, VOFF = 2 * KBYTES, POSOFF = 2 * KBYTES + 3 * VBYTES;
    constexpr int VBATCH = VBYTES / 8192;
    static_assert(POSOFF + 512 <= 131072 + 2048, "attention LDS");
    const int tid = threadIdx.x, lane = tid & 63, r32 = lane & 31, hi = lane >> 5; const int wid = __builtin_amdgcn_readfirstlane(tid >> 6);
    const int grp = wid >> 2;
    const int qrow0 = q0 + 32 * wid, qidx = qrow0 + r32;
    const int NT = (q0 + 256) / 64;
    bf16x8 qr[NSTEP];
    { const bf16_t* qp = A.Q + (size_t)qidx * A.qpitch + 8 * hi;
#pragma unroll
      for (int s = 0; s < NSTEP; ++s) qr[s] = *(const bf16x8*)(qp + 16 * s); }
    const float pqf = (MODE == 0) ? A.posf[qidx] : 0.f;
    const int krow_ = tid >> 3, kch_ = (tid & 7) ^ ((krow_ >> 1) & 7);
    const unsigned kofs = (unsigned)(krow_ * A.kpitch + kch_ * 8) * 2u;
    const unsigned k2ofs = (MODE == 1) ? (unsigned)(krow_ * A.k2pitch + kch_ * 8) * 2u : 0u;
    const unsigned vofs = (unsigned)((((tid >> 5) / NDB) * 8 + ((tid >> 2) & 7)) * A.vpitch + ((tid >> 5) % NDB) * 32 + (tid & 3) * 8) * 2u;
    auto issueK = [&](int t, int) {
        const unsigned dst = (unsigned)__builtin_amdgcn_readfirstlane((int)(unsigned)(uintptr_t)(lds + KOFF + (t & 1) * KBYTES + wid * 1024));
        const char* kb0 = (const char*)(A.K + (size_t)t * 64 * A.kpitch) + kofs;
        glds16(kb0, dst); glds16(kb0 + 128, dst + 8192);
        if (MODE == 1) glds16((const char*)(A.K2 + (size_t)t * 64 * A.k2pitch) + k2ofs, dst + 16384);
        if (MODE == 0) { if (lane < 16) glds16(A.posf + t * 64 + lane * 4, (unsigned)__builtin_amdgcn_readfirstlane((int)(unsigned)(uintptr_t)(lds + POSOFF + (t & 1) * 256))); }
    };
    auto issueV = [&](int t, int) {
        const unsigned dst = (unsigned)__builtin_amdgcn_readfirstlane((int)(unsigned)(uintptr_t)(lds + VOFF + (t % 3) * VBYTES + wid * 1024));
        const char* vb0 = (const char*)(A.V + (size_t)t * 64 * A.vpitch) + vofs;
#pragma unroll
        for (int rd = 0; rd < VBATCH; ++rd) glds16(vb0 + (size_t)rd * (128 / NDB) * A.vpitch * 2, dst + rd * 8192);
    };
    { int tq = tid; asm volatile("" : "+v"(tq)); issueK(0, tq); issueV(0, tq); }
#pragma unroll
    for (int db = 0; db < NDB; ++db)
#pragma unroll
        for (int r = 0; r < 16; ++r) o[db][r] = 0.f;
    float mrun = -1.0e30f, lrun = 0.f;
    const float k2 = (MODE == 0) ? A.slope2 / A.c1 : 0.f;
    bf16x8 pa[4];
#pragma unroll
    for (int i = 0; i < 4; ++i) pa[i] = (bf16x8){0, 0, 0, 0, 0, 0, 0, 0};

    auto qks = [&](int t, int tq) {
        if (64 * t > qrow0 + 31) return;
        const int lq = tq & 63, r32q = lq & 31, hiq = lq >> 5;
        const int koff = r32q * 128, kx = (r32q >> 1) & 7;
        const ALAS unsigned char* kbuf = lds + KOFF + (t & 1) * KBYTES;
        f32x16 s0, s1;
#pragma unroll
        for (int r = 0; r < 16; ++r) { s0[r] = 0.f; s1[r] = 0.f; }
        __builtin_amdgcn_s_setprio(2);
#pragma unroll
        for (int s = 0; s < NSTEP; ++s) {
            const int kb = s >> 2, ch = 2 * (s & 3) + hiq;
            const ALAS unsigned char* p = kbuf + kb * 8192 + koff + ((ch ^ kx) * 16);
            const bf16x8 k0 = *(const ALAS bf16x8*)p, k1 = *(const ALAS bf16x8*)(p + 4096);
            s0 = __builtin_amdgcn_mfma_f32_32x32x16_bf16(k0, qr[s], s0, 0, 0, 0);
            s1 = __builtin_amdgcn_mfma_f32_32x32x16_bf16(k1, qr[s], s1, 0, 0, 0);

        }
        __builtin_amdgcn_s_setprio(0);
        if (MODE == 0) {
            const ALAS float* pk = (const ALAS float*)(lds + POSOFF + (t & 1) * 256);
#pragma unroll
            for (int g = 0; g < 4; ++g) {
                const f32x4 p0 = *(const ALAS f32x4*)(pk + 8 * g + 4 * hiq), p1 = *(const ALAS f32x4*)(pk + 32 + 8 * g + 4 * hiq);
#pragma unroll
                for (int j = 0; j < 4; ++j) {
                    s0[4 * g + j] = __builtin_fmaf(-k2, __builtin_fabsf(pqf - p0[j]), s0[4 * g + j]);
                    s1[4 * g + j] = __builtin_fmaf(-k2, __builtin_fabsf(pqf - p1[j]), s1[4 * g + j]);
                }
            }
        }
        if (64 * t + 63 > qrow0) {
#pragma unroll
            for (int r = 0; r < 16; ++r) { const int kv = 64 * t + crow(r, hi); if (kv > qidx) s0[r] = -INFINITY; if (kv + 32 > qidx) s1[r] = -INFINITY; }
        }
        if (MODE == 1) asm volatile("s_nop 15\n\ts_nop 7" : "+v"(s0), "+v"(s1));
        float mx = rowmax32(s0, s1);
        { auto rr = __builtin_amdgcn_permlane32_swap(__float_as_uint(mx), __float_as_uint(mx), false, false); mx = __builtin_fmaxf(__uint_as_float(rr[0]), __uint_as_float(rr[1])); }
        if (__any(mx > mrun)) {
            const float mnew = __builtin_fmaxf(mrun, mx);
            const float alpha = __builtin_amdgcn_exp2f((mrun - mnew) * A.c1);
            mrun = mnew; lrun *= alpha;
#pragma unroll
            for (int db = 0; db < NDB; ++db)
#pragma unroll
                for (int r = 0; r < 16; ++r) o[db][r] *= alpha;
        }
        const float nm = -mrun * A.c1;
        lrun += exp_sum32(s0, s1, A.c1, nm);
        { u32x4 w;
          w.x = cvtpk(s0[0], s0[1]); w.y = cvtpk(s0[2], s0[3]); w.z = cvtpk(s0[4], s0[5]); w.w = cvtpk(s0[6], s0[7]); pa[0] = __builtin_bit_cast(bf16x8, w);
          w.x = cvtpk(s0[8], s0[9]); w.y = cvtpk(s0[10], s0[11]); w.z = cvtpk(s0[12], s0[13]); w.w = cvtpk(s0[14], s0[15]); pa[1] = __builtin_bit_cast(bf16x8, w);
          w.x = cvtpk(s1[0], s1[1]); w.y = cvtpk(s1[2], s1[3]); w.z = cvtpk(s1[4], s1[5]); w.w = cvtpk(s1[6], s1[7]); pa[2] = __builtin_bit_cast(bf16x8, w);
          w.x = cvtpk(s1[8], s1[9]); w.y = cvtpk(s1[10], s1[11]); w.z = cvtpk(s1[12], s1[13]); w.w = cvtpk(s1[14], s1[15]); pa[3] = __builtin_bit_cast(bf16x8, w); }
    };
    auto pv = [&](int t, int tq) {
        if (64 * t > qrow0 + 31) return;
        const int lq = tq & 63, hiq = lq >> 5;
        const int voff = (4 * hiq + ((lq & 15) >> 2)) * 64 + ((lq >> 4) & 1) * 32 + (lq & 3) * 8;
        const ALAS unsigned char* vbuf = lds + VOFF + (t % 3) * VBYTES;
#pragma unroll
        for (int db = 0; db < NDB; ++db) {
#pragma unroll
            for (int ks = 0; ks < 4; ++ks) {
                const ALAS unsigned char* vp = vbuf + ((2 * ks) * NDB + db) * 512 + voff;
                const s16x4 lo = vtr(vp), hh = vtr(vp + NDB * 512);
                const bf16x8 vf = (bf16x8){lo[0], lo[1], lo[2], lo[3], hh[0], hh[1], hh[2], hh[3]};
                o[db] = __builtin_amdgcn_mfma_f32_32x32x16_bf16(vf, pa[ks], o[db], 0, 0, 0);
            }

        }
    };
    if (grp == 0) {
        for (int t = 0; t <= NT; ++t) {
            ATT_WAITV(0);
            __builtin_amdgcn_s_barrier();
            asm volatile("" ::: "memory");
            int tq = tid; asm volatile("" : "+v"(tq));
            if (t + 1 < NT) { issueK(t + 1, tq); issueV(t + 1, tq); }
            if (t < NT) { qks(t, tq); pv(t, tq); }
        }
    } else {
        for (int t = 0; t <= NT; ++t) {
            ATT_WAITV(0);
            __builtin_amdgcn_s_barrier();
            asm volatile("" ::: "memory");
            int tq = tid; asm volatile("" : "+v"(tq));
            if (t + 1 < NT) { issueK(t + 1, tq); issueV(t + 1, tq); }
            if (t >= 1) pv(t - 1, tq);
            if (t < NT) qks(t, tq);
        }
    }
    asm volatile("s_waitcnt lgkmcnt(0)" ::: "memory");
    __syncthreads();
    const float lt = lrun + __shfl_xor(lrun, 32);
    return 1.0f / lt;
}

__device__ __forceinline__ float attn_mla_lag(ALAS unsigned char* lds, const Args& A, int q0, f32x16 (&o)[4]) {
    constexpr int KBYTES = 24576, VBYTES = 16384, KOFF = 0, VOFF = 2 * KBYTES, NSTEP = 12, NDB = 4;
    const int tid = threadIdx.x, lane = tid & 63, r32 = lane & 31, hi = lane >> 5; const int wid = __builtin_amdgcn_readfirstlane(tid >> 6);
    const int qrow0 = q0 + 32 * wid, qidx = qrow0 + r32;
    const int NT = (q0 + 256) / 64, ta = qrow0 >> 6;
    bf16x8 qr[NSTEP];
    { const bf16_t* qp = A.Q + (size_t)qidx * A.qpitch + 8 * hi;
#pragma unroll
      for (int s = 0; s < NSTEP; ++s) qr[s] = *(const bf16x8*)(qp + 16 * s); }
    const int krow_ = tid >> 3, kch_ = (tid & 7) ^ ((krow_ >> 1) & 7);
    const unsigned kofs = (unsigned)(krow_ * A.kpitch + kch_ * 8) * 2u;
    const unsigned k2ofs = (unsigned)(krow_ * A.k2pitch + kch_ * 8) * 2u;
    const unsigned vofs = (unsigned)((((tid >> 5) / NDB) * 8 + ((tid >> 2) & 7)) * A.vpitch + ((tid >> 5) % NDB) * 32 + (tid & 3) * 8) * 2u;
    auto issueK = [&](int t) {
        const unsigned dst = (unsigned)__builtin_amdgcn_readfirstlane((int)(unsigned)(uintptr_t)(lds + KOFF + (t & 1) * KBYTES + wid * 1024));
        const char* kb0 = (const char*)(A.K + (size_t)t * 64 * A.kpitch) + kofs;
        glds16(kb0, dst); glds16(kb0 + 128, dst + 8192);
        glds16((const char*)(A.K2 + (size_t)t * 64 * A.k2pitch) + k2ofs, dst + 16384);
    };
    auto issueV = [&](int t) {
        const unsigned dst = (unsigned)__builtin_amdgcn_readfirstlane((int)(unsigned)(uintptr_t)(lds + VOFF + (t & 1) * VBYTES + wid * 1024));
        const char* vb0 = (const char*)(A.V + (size_t)t * 64 * A.vpitch) + vofs;
        glds16(vb0, dst); glds16(vb0 + (size_t)32 * A.vpitch * 2, dst + 8192);
    };
#pragma unroll
    for (int db = 0; db < NDB; ++db)
#pragma unroll
        for (int r = 0; r < 16; ++r) o[db][r] = 0.f;
    float mrun = -1.0e30f, lrun = 0.f;
    bf16x8 pa[4];
#pragma unroll
    for (int i = 0; i < 4; ++i) pa[i] = (bf16x8){0, 0, 0, 0, 0, 0, 0, 0};
    const int koff = r32 * 128, kx = (r32 >> 1) & 7;
    const int voff = (4 * hi + ((lane & 15) >> 2)) * 64 + ((lane >> 4) & 1) * 32 + (lane & 3) * 8;
    f32x16 s0, s1;
    auto qk = [&](int t) {
        const ALAS unsigned char* kbuf = lds + KOFF + (t & 1) * KBYTES;
        const f32x16 z = {0.f, 0.f, 0.f, 0.f, 0.f, 0.f, 0.f, 0.f, 0.f, 0.f, 0.f, 0.f, 0.f, 0.f, 0.f, 0.f};
#pragma unroll
        for (int s = 0; s < NSTEP; ++s) {
            const int kb = s >> 2, ch = 2 * (s & 3) + hi;
            const ALAS unsigned char* p = kbuf + kb * 8192 + koff + ((ch ^ kx) * 16);
            const bf16x8 k0 = *(const ALAS bf16x8*)p, k1 = *(const ALAS bf16x8*)(p + 4096);
            s0 = __builtin_amdgcn_mfma_f32_32x32x16_bf16(k0, qr[s], s == 0 ? z : s0, 0, 0, 0);
            s1 = __builtin_amdgcn_mfma_f32_32x32x16_bf16(k1, qr[s], s == 0 ? z : s1, 0, 0, 0);
        }
        asm volatile("s_nop 15\n\ts_nop 7" : "+v"(s0), "+v"(s1));
    };
    auto pvl = [&](int t) {
        const ALAS unsigned char* vbuf = lds + VOFF + (t & 1) * VBYTES;
#pragma unroll
        for (int db = 0; db < NDB; ++db) {
#pragma unroll
            for (int ks = 0; ks < 4; ++ks) {
                const ALAS unsigned char* vp = vbuf + ((2 * ks) * NDB + db) * 512 + voff;
                const s16x4 lo = vtr(vp), hh = vtr(vp + NDB * 512);
                const bf16x8 vf = (bf16x8){lo[0], lo[1], lo[2], lo[3], hh[0], hh[1], hh[2], hh[3]};
                o[db] = __builtin_amdgcn_mfma_f32_32x32x16_bf16(vf, pa[ks], o[db], 0, 0, 0);
            }
        }
    };
    auto packp = [&]() {
        u32x4 w;
        w.x = cvtpk(s0[0], s0[1]); w.y = cvtpk(s0[2], s0[3]); w.z = cvtpk(s0[4], s0[5]); w.w = cvtpk(s0[6], s0[7]); pa[0] = __builtin_bit_cast(bf16x8, w);
        w.x = cvtpk(s0[8], s0[9]); w.y = cvtpk(s0[10], s0[11]); w.z = cvtpk(s0[12], s0[13]); w.w = cvtpk(s0[14], s0[15]); pa[1] = __builtin_bit_cast(bf16x8, w);
        w.x = cvtpk(s1[0], s1[1]); w.y = cvtpk(s1[2], s1[3]); w.z = cvtpk(s1[4], s1[5]); w.w = cvtpk(s1[6], s1[7]); pa[2] = __builtin_bit_cast(bf16x8, w);
        w.x = cvtpk(s1[8], s1[9]); w.y = cvtpk(s1[10], s1[11]); w.z = cvtpk(s1[12], s1[13]); w.w = cvtpk(s1[14], s1[15]); pa[3] = __builtin_bit_cast(bf16x8, w);
    };
    auto top = [&](int t) {
        ATT_WAITV(0);
        __builtin_amdgcn_s_barrier();
        asm volatile("" ::: "memory");
        if (t + 1 < NT) issueK(t + 1);
        if (t < NT) issueV(t);
    };
    auto gen = [&](int t) {
        top(t);
        const bool act = t <= ta && t < NT;
        if (act) qk(t);
        if (t >= 1 && t - 1 <= ta) pvl(t - 1);
        if (act) {
            if (64 * t + 63 > qrow0) {
#pragma unroll
                for (int r = 0; r < 16; ++r) { const int kv = 64 * t + crow(r, hi); if (kv > qidx) s0[r] = -INFINITY; if (kv + 32 > qidx) s1[r] = -INFINITY; }
            }
            float mx = rowmax32(s0, s1);
            { auto rr = __builtin_amdgcn_permlane32_swap(__float_as_uint(mx), __float_as_uint(mx), false, false); mx = __builtin_fmaxf(__uint_as_float(rr[0]), __uint_as_float(rr[1])); }
            if (__any(mx > mrun)) {
                const float mnew = __builtin_fmaxf(mrun, mx);
                const float alpha = __builtin_amdgcn_exp2f((mrun - mnew) * A.c1);
                mrun = mnew; lrun *= alpha;
#pragma unroll
                for (int db = 0; db < NDB; ++db)
#pragma unroll
                    for (int r = 0; r < 16; ++r) o[db][r] *= alpha;
            }
            lrun += exp_sum32(s0, s1, A.c1, -mrun * A.c1);
            packp();
        }
    };
    issueK(0);
    gen(0);
#pragma unroll 1
    for (int t = 1; t < ta; ++t) {
        top(t);
        qk(t);
        float alpha;
        {
            const ALAS unsigned char* vbuf = lds + VOFF + ((t - 1) & 1) * VBYTES;
#define MLA_PVM(i) do { const int ks_ = (i) >> 2, db_ = (i) & 3; const ALAS unsigned char* vp_ = vbuf + ((2 * ks_) * NDB + db_) * 512 + voff; \
            const s16x4 lo_ = vtr(vp_), hh_ = vtr(vp_ + NDB * 512); const bf16x8 vf_ = (bf16x8){lo_[0], lo_[1], lo_[2], lo_[3], hh_[0], hh_[1], hh_[2], hh_[3]}; \
            o[db_] = __builtin_amdgcn_mfma_f32_32x32x16_bf16(vf_, pa[ks_], o[db_], 0, 0, 0); } while (0)
#define MLA_F() __builtin_amdgcn_sched_barrier(0)
#define MLA_EXPS(r) do { f32x2 a_ = (f32x2){s0[r], s0[r + 1]} * A.c1 + nm, b_ = (f32x2){s1[r], s1[r + 1]} * A.c1 + nm; \
            a_.x = __builtin_amdgcn_exp2f(a_.x); a_.y = __builtin_amdgcn_exp2f(a_.y); b_.x = __builtin_amdgcn_exp2f(b_.x); b_.y = __builtin_amdgcn_exp2f(b_.y); \
            s0[r] = a_.x; s0[r + 1] = a_.y; s1[r] = b_.x; s1[r + 1] = b_.y; acc += a_; acc += b_; } while (0)
            float ma, mb;
            MLA_PVM(0); ma = max3f(s0[0], s0[1], s1[0]); mb = max3f(s0[2], s0[3], s1[1]); ma = max3f(ma, s1[2], s1[3]); ma = max3f(ma, s0[4], s0[5]); mb = max3f(mb, s0[6], s0[7]); ma = max3f(ma, s1[4], s1[5]); MLA_F();
            MLA_PVM(1); mb = max3f(mb, s1[6], s1[7]); ma = max3f(ma, s0[8], s0[9]); mb = max3f(mb, s0[10], s0[11]); ma = max3f(ma, s1[8], s1[9]); mb = max3f(mb, s1[10], s1[11]); ma = max3f(ma, s0[12], s0[13]); MLA_F();
            MLA_PVM(2); mb = max3f(mb, s0[14], s0[15]); ma = max3f(ma, s1[12], s1[13]); mb = max3f(mb, s1[14], s1[15]); float mx = max3f(ma, mb, mb); MLA_F();
            MLA_PVM(3);
            { auto rr = __builtin_amdgcn_permlane32_swap(__float_as_uint(mx), __float_as_uint(mx), false, false); mx = __builtin_fmaxf(__uint_as_float(rr[0]), __uint_as_float(rr[1])); }
            const float mnew = __builtin_fmaxf(mrun, mx);
            alpha = __builtin_amdgcn_exp2f((mrun - mnew) * A.c1);
            mrun = mnew;
            const float nm = -mrun * A.c1;
            f32x2 acc = {0.f, 0.f};
            MLA_F();
            MLA_PVM(4); MLA_EXPS(0); MLA_F();
            MLA_PVM(5); MLA_EXPS(2); MLA_F();
            MLA_PVM(6); MLA_EXPS(4); MLA_F();
            MLA_PVM(7); MLA_EXPS(6); MLA_F();
            MLA_PVM(8); MLA_EXPS(8); MLA_F();
            MLA_PVM(9); MLA_EXPS(10); MLA_F();
            MLA_PVM(10); MLA_EXPS(12); MLA_F();
            MLA_PVM(11); MLA_EXPS(14); MLA_F();
            MLA_PVM(12); lrun = __builtin_fmaf(lrun, alpha, acc.x + acc.y);
            { u32x4 w; w.x = cvtpk(s0[0], s0[1]); w.y = cvtpk(s0[2], s0[3]); w.z = cvtpk(s0[4], s0[5]); w.w = cvtpk(s0[6], s0[7]); pa[0] = __builtin_bit_cast(bf16x8, w); } MLA_F();
            MLA_PVM(13); { u32x4 w; w.x = cvtpk(s0[8], s0[9]); w.y = cvtpk(s0[10], s0[11]); w.z = cvtpk(s0[12], s0[13]); w.w = cvtpk(s0[14], s0[15]); pa[1] = __builtin_bit_cast(bf16x8, w); } MLA_F();
            MLA_PVM(14); { u32x4 w; w.x = cvtpk(s1[0], s1[1]); w.y = cvtpk(s1[2], s1[3]); w.z = cvtpk(s1[4], s1[5]); w.w = cvtpk(s1[6], s1[7]); pa[2] = __builtin_bit_cast(bf16x8, w); } MLA_F();
            MLA_PVM(15); MLA_F();
            { u32x4 w; w.x = cvtpk(s1[8], s1[9]); w.y = cvtpk(s1[10], s1[11]); w.z = cvtpk(s1[12], s1[13]); w.w = cvtpk(s1[14], s1[15]); pa[3] = __builtin_bit_cast(bf16x8, w); }
#undef MLA_PVM
#undef MLA_F
#undef MLA_EXPS
        }
        __builtin_amdgcn_sched_barrier(0);
        if (__any(alpha != 1.0f)) {
#pragma unroll
            for (int db = 0; db < NDB; ++db)
#pragma unroll
                for (int r = 0; r < 16; ++r) o[db][r] *= alpha;
        }
    }
#pragma unroll 1
    for (int t = (ta > 1 ? ta : 1); t <= NT; ++t) gen(t);
    asm volatile("s_waitcnt lgkmcnt(0)" ::: "memory");
    __syncthreads();
    const float lt = lrun + __shfl_xor(lrun, 32);
    return 1.0f / lt;
}
constexpr int PR_K = 0, PR_V = 32768, PR_POS = 131072, PR_P = 131072 + 512, PR_AL = PR_P + 16384, PR_FLAG = PR_AL + 1024, PR_X = PR_FLAG + 256, PR_BND = PR_X + 4096, PR_STOP = PR_BND + 3072, PR_END = PR_STOP + 64;
__device__ __forceinline__ float attn_diff_pair(ALAS unsigned char* lds, const Args& A, int q0, f32x16 (&o)[4]) {
    const int tid = threadIdx.x, lane = tid & 63, r32 = lane & 31, hi = lane >> 5; const int wid = __builtin_amdgcn_readfirstlane(tid >> 6);
    const int pw = wid & 3;
    const bool prod = wid < 4;
    const int qrow0 = q0 + 32 * pw, qidx = qrow0 + r32;
    const int NT = (q0 + 128) / 64;
    bf16x8 qr[8];
    float pqs = 0.f, qn = 0.f;
    if (prod) {
        const bf16_t* qp = A.Q + (size_t)qidx * A.qpitch + 8 * hi;
#pragma unroll
        for (int s = 0; s < 8; ++s) qr[s] = *(const bf16x8*)(qp + 16 * s);
        pqs = A.posf[qidx];
        float ssq = 0.f;
#pragma unroll
        for (int s = 0; s < 8; ++s)
#pragma unroll
            for (int j = 0; j < 8; ++j) { const float v = __uint_as_float(((unsigned)(unsigned short)qr[s][j]) << 16); ssq += v * v; }
        ssq += __shfl_xor(ssq, 32);
        qn = sqrtf(ssq) * 1.002f;
    } else {
#pragma unroll
        for (int s = 0; s < 8; ++s) qr[s] = (bf16x8){0, 0, 0, 0, 0, 0, 0, 0};
    }
    const int l0 = tid - 256;
    const unsigned kofs = (unsigned)((l0 >> 3) * A.kpitch + (((l0 & 7) ^ ((l0 >> 4) & 7)) * 8)) * 2u;
    const unsigned vofs = (unsigned)(((l0 >> 2) & 7) * A.vpitch + (l0 >> 5) * 32 + (l0 & 3) * 8) * 2u;
    auto issueKV = [&](int t, int st) {
        const char* kb = (const char*)(A.K + (size_t)t * 64 * A.kpitch) + kofs;
        const char* vbp = (const char*)(A.V + (size_t)t * 64 * A.vpitch) + vofs;
        const unsigned kdst = (unsigned)__builtin_amdgcn_readfirstlane((int)(unsigned)(uintptr_t)(lds + PR_K + (st & 1) * 16384 + (wid - 4) * 1024));
        const unsigned vdst = (unsigned)__builtin_amdgcn_readfirstlane((int)(unsigned)(uintptr_t)(lds + PR_V + (st % 3) * 32768 + (wid - 4) * 1024));
#pragma unroll
        for (int v = 0; v < 2; ++v) { const char* ksrc = kb + (size_t)v * 32 * A.kpitch * 2;
            glds16(ksrc, kdst + v * 4096); glds16(ksrc + 128, kdst + v * 4096 + 8192); }
        if (lane < 16) glds16(A.posf + t * 64 + lane * 4, (unsigned)__builtin_amdgcn_readfirstlane((int)(unsigned)(uintptr_t)(lds + PR_POS + (st & 1) * 256)));
#pragma unroll
        for (int v = 0; v < 2; ++v)
#pragma unroll
            for (int rd = 0; rd < 4; ++rd) glds16(vbp + (size_t)(v * 8 + rd * 16) * A.vpitch * 2, vdst + v * 4096 + rd * 8192);
    };
    if (!prod) issueKV(NT - 1, 0);
    ALAS float* bnd = (ALAS float*)(lds + PR_BND);
    volatile ALAS unsigned* stopw = (volatile ALAS unsigned*)(lds + PR_STOP);
    if (wid == 4) {
        f32x4 km = *((const f32x4*)A.kmaxt + lane), px = *((const f32x4*)A.pmaxt + lane), pn = *((const f32x4*)A.pmint + lane);
        km.y = __builtin_fmaxf(km.x, km.y); km.z = __builtin_fmaxf(km.y, km.z); km.w = __builtin_fmaxf(km.z, km.w);
        px.y = __builtin_fmaxf(px.x, px.y); px.z = __builtin_fmaxf(px.y, px.z); px.w = __builtin_fmaxf(px.z, px.w);
        pn.y = __builtin_fminf(pn.x, pn.y); pn.z = __builtin_fminf(pn.y, pn.z); pn.w = __builtin_fminf(pn.z, pn.w);
        float tk = km.w, tx = px.w, tn = pn.w;
#pragma unroll
        for (int d = 1; d < 64; d <<= 1) { const float a = __shfl_up(tk, d), b = __shfl_up(tx, d), c = __shfl_up(tn, d); if (lane >= d) { tk = __builtin_fmaxf(tk, a); tx = __builtin_fmaxf(tx, b); tn = __builtin_fminf(tn, c); } }
        float ek = __shfl_up(tk, 1), ex = __shfl_up(tx, 1), en = __shfl_up(tn, 1);
        if (lane == 0) { ek = 0.f; ex = -3.0e38f; en = 3.0e38f; }
#pragma unroll
        for (int j = 0; j < 4; ++j) { km[j] = __builtin_fmaxf(km[j], ek); px[j] = __builtin_fmaxf(px[j], ex); pn[j] = __builtin_fminf(pn[j], en); }
        *((ALAS f32x4*)bnd + lane) = km; *((ALAS f32x4*)(bnd + 256) + lane) = px; *((ALAS f32x4*)(bnd + 512) + lane) = pn;
        if (lane < 8) stopw[lane] = 0u;
    }
    int nsteps = NT;
    volatile ALAS unsigned* flagp = (volatile ALAS unsigned*)(lds + PR_FLAG) + pw;
    if (prod && lane == 0) *flagp = 0u;
#pragma unroll
    for (int db = 0; db < 4; ++db)
#pragma unroll
        for (int r = 0; r < 16; ++r) o[db][r] = 0.f;
    float mrun = -1.0e30f, lrun = 0.f;
    bf16x8 pa[4];
#pragma unroll
    for (int i = 0; i < 4; ++i) pa[i] = (bf16x8){0, 0, 0, 0, 0, 0, 0, 0};
    ALAS unsigned char* pslot = lds + PR_P + pw * 4096 + lane * 16;
    ALAS float* aslot = (ALAS float*)(lds + PR_AL + pw * 256) + lane;
#define ATT_FENCE() __builtin_amdgcn_sched_barrier(0)
    bf16x8 fa[4], fb[4];
    f32x16 s0, s1;
    auto ldK = [&](bf16x8 (&f)[4], int b, const ALAS unsigned char* kbuf, int koff, int kx, int hiq) {
#pragma unroll
        for (int i = 0; i < 2; ++i) { const int s = 2 * b + i, kb = s >> 2, ch = 2 * (s & 3) + hiq;
            const ALAS unsigned char* p = kbuf + kb * 8192 + koff + ((ch ^ kx) * 16);
            f[2 * i] = *(const ALAS bf16x8*)p; f[2 * i + 1] = *(const ALAS bf16x8*)(p + 4096); }
    };
    auto mmK = [&](const bf16x8 (&f)[4], int b) {
#pragma unroll
        for (int i = 0; i < 2; ++i) { const int s = 2 * b + i;
            if (s == 0) { const f32x16 z = {0.f, 0.f, 0.f, 0.f, 0.f, 0.f, 0.f, 0.f, 0.f, 0.f, 0.f, 0.f, 0.f, 0.f, 0.f, 0.f};
                s0 = __builtin_amdgcn_mfma_f32_32x32x16_bf16(f[0], qr[0], z, 0, 0, 0); s1 = __builtin_amdgcn_mfma_f32_32x32x16_bf16(f[1], qr[0], z, 0, 0, 0); }
            else {
            s0 = __builtin_amdgcn_mfma_f32_32x32x16_bf16(f[2 * i], qr[s], s0, 0, 0, 0);
            s1 = __builtin_amdgcn_mfma_f32_32x32x16_bf16(f[2 * i + 1], qr[s], s1, 0, 0, 0); } }
    };
    auto ldV = [&](bf16x8 (&f)[4], int ks, const ALAS unsigned char* vb) {
#pragma unroll
        for (int db = 0; db < 4; ++db) { const ALAS unsigned char* vp = vb + ((2 * ks) * 8 + db) * 512;
            const s16x4 lo = vtr(vp), hh = vtr(vp + 8 * 512);
            f[db] = (bf16x8){lo[0], lo[1], lo[2], lo[3], hh[0], hh[1], hh[2], hh[3]}; }
    };
    auto mmV = [&](const bf16x8 (&f)[4], int ks) {
#pragma unroll
        for (int db = 0; db < 4; ++db) o[db] = __builtin_amdgcn_mfma_f32_32x32x16_bf16(f[db], pa[ks], o[db], 0, 0, 0);
    };
    if (prod) {
        __builtin_amdgcn_s_setprio(3);
        for (int it = 0; it <= nsteps; ++it) {
            __builtin_amdgcn_s_barrier();
            asm volatile("" ::: "memory");
            if (it >= 1) { const unsigned sv = stopw[((it - 1) & 1) * 4] & stopw[((it - 1) & 1) * 4 + 1] & stopw[((it - 1) & 1) * 4 + 2] & stopw[((it - 1) & 1) * 4 + 3];
                if (__builtin_amdgcn_readfirstlane((int)sv) != 0 && it < nsteps) nsteps = it; }
            const int t = NT - 1 - it;
            int tq = tid; asm volatile("" : "+v"(tq));
            const bool act = (it < nsteps) && (64 * t <= qrow0 + 31);
            const bool actp = (it >= 1) && (64 * (t + 1) <= qrow0 + 31);
            const int lq = tq & 63, r32q = lq & 31, hiq = lq >> 5;
            const int koff = r32q * 128, kx = (r32q >> 1) & 7;
            const int voff = (4 * hiq + ((lq & 15) >> 2)) * 64 + ((lq >> 4) & 1) * 32 + (lq & 3) * 8;
            const ALAS unsigned char* kbuf = lds + PR_K + (it & 1) * 16384;
            const ALAS unsigned char* vb = lds + PR_V + ((it + 2) % 3) * 32768 + voff;
            if (act) {
                ldK(fa, 0, kbuf, koff, kx, hiq); ldK(fb, 1, kbuf, koff, kx, hiq); ATT_FENCE();
                mmK(fa, 0); ATT_FENCE(); ldK(fa, 2, kbuf, koff, kx, hiq); ATT_FENCE();
                mmK(fb, 1); ATT_FENCE(); ldK(fb, 3, kbuf, koff, kx, hiq); ATT_FENCE();
                mmK(fa, 2); ATT_FENCE();
            }
            if (actp) { ldV(fa, 0, vb); ATT_FENCE(); }
            if (act) { mmK(fb, 3); ATT_FENCE(); }
            if (actp) {
                ldV(fb, 1, vb); ATT_FENCE();
                mmV(fa, 0); ATT_FENCE(); ldV(fa, 2, vb); ATT_FENCE();
                mmV(fb, 1); ATT_FENCE(); ldV(fb, 3, vb); ATT_FENCE();
                mmV(fa, 2); ATT_FENCE(); mmV(fb, 3); ATT_FENCE();
            }
            if (act) {
                const ALAS float* pk = (const ALAS float*)(lds + PR_POS + (it & 1) * 256);
                const f32x4 pq4 = {pqs, pqs, pqs, pqs};
#pragma unroll
                for (int g = 0; g < 4; ++g) {
                    const f32x4 p0 = *(const ALAS f32x4*)(pk + 8 * g + 4 * hiq), p1 = *(const ALAS f32x4*)(pk + 32 + 8 * g + 4 * hiq);
                    const f32x4 d0 = pq4 - p0, d1 = pq4 - p1;
#pragma unroll
                    for (int j = 0; j < 4; ++j) {
                        s0[4 * g + j] = s0[4 * g + j] - __builtin_fabsf(d0[j]);
                        s1[4 * g + j] = s1[4 * g + j] - __builtin_fabsf(d1[j]);
                    }
                }
                if (64 * t + 63 > qrow0) {
#pragma unroll
                    for (int r = 0; r < 16; ++r) { const int kv = 64 * t + crow(r, hi); if (kv > qidx) s0[r] = -INFINITY; if (kv + 32 > qidx) s1[r] = -INFINITY; }
                }
                float mx = rowmax32(s0, s1);
                { auto rr = __builtin_amdgcn_permlane32_swap(__float_as_uint(mx), __float_as_uint(mx), false, false); mx = __builtin_fmaxf(__uint_as_float(rr[0]), __uint_as_float(rr[1])); }
                float alpha = 1.0f;
                if (__any(mx > mrun)) {
                    const float mnew = __builtin_fmaxf(mrun, mx);
                    alpha = __builtin_amdgcn_exp2f((mrun - mnew) * A.c1);
                    mrun = mnew; lrun *= alpha;
#pragma unroll
                    for (int db = 0; db < 4; ++db)
#pragma unroll
                        for (int r = 0; r < 16; ++r) o[db][r] *= alpha;
                }
                const float nm = -mrun * A.c1;
                lrun += exp_sum32(s0, s1, A.c1, nm);
                { u32x4 w;
                  w.x = cvtpk(s0[0], s0[1]); w.y = cvtpk(s0[2], s0[3]); w.z = cvtpk(s0[4], s0[5]); w.w = cvtpk(s0[6], s0[7]); pa[0] = __builtin_bit_cast(bf16x8, w);
                  w.x = cvtpk(s0[8], s0[9]); w.y = cvtpk(s0[10], s0[11]); w.z = cvtpk(s0[12], s0[13]); w.w = cvtpk(s0[14], s0[15]); pa[1] = __builtin_bit_cast(bf16x8, w);
                  w.x = cvtpk(s1[0], s1[1]); w.y = cvtpk(s1[2], s1[3]); w.z = cvtpk(s1[4], s1[5]); w.w = cvtpk(s1[6], s1[7]); pa[2] = __builtin_bit_cast(bf16x8, w);
                  w.x = cvtpk(s1[8], s1[9]); w.y = cvtpk(s1[10], s1[11]); w.z = cvtpk(s1[12], s1[13]); w.w = cvtpk(s1[14], s1[15]); pa[3] = __builtin_bit_cast(bf16x8, w); }
                if (actp) { while (*flagp != (unsigned)it) __builtin_amdgcn_s_sleep(1); }
                asm volatile("" ::: "memory");
#pragma unroll
                for (int ks = 0; ks < 4; ++ks) *(ALAS bf16x8*)(pslot + ks * 1024) = pa[ks];
                *aslot = alpha;
            }
            if (it < nsteps) {
                unsigned vote = 0u;
                if (act && t >= 1) {
                    const float ks = bnd[t - 1], px = bnd[256 + t - 1], pn = bnd[512 + t - 1];
                    const float ds = __builtin_fmaxf(0.f, __builtin_fmaxf(pqs - px, pn - pqs));
                    vote = __all(qn * ks - ds - mrun < -1200.0f) ? 1u : 0u;
                }
                if (lane == 0) stopw[(it & 1) * 4 + pw] = vote;
            }
            asm volatile("s_waitcnt lgkmcnt(0)" ::: "memory");
        }
        __builtin_amdgcn_s_setprio(0);
    } else {
        for (int it = 0; it <= nsteps; ++it) {
            if (it < NT) ATT_WAITV(8); else ATT_WAITV(0);
            __builtin_amdgcn_s_barrier();
            asm volatile("" ::: "memory");
            if (it >= 1) { const unsigned sv = stopw[((it - 1) & 1) * 4] & stopw[((it - 1) & 1) * 4 + 1] & stopw[((it - 1) & 1) * 4 + 2] & stopw[((it - 1) & 1) * 4 + 3];
                if (__builtin_amdgcn_readfirstlane((int)sv) != 0 && it < nsteps) nsteps = it; }
            const int t = NT - 1 - it;
            int tq = tid; asm volatile("" : "+v"(tq));
            if (it + 1 < nsteps) issueKV(t - 1, it + 1);
            const bool actp = (it >= 1) && (64 * (t + 1) <= qrow0 + 31);
            if (actp) {
                const int lq = tq & 63, hiq = lq >> 5;
                const int voff = (4 * hiq + ((lq & 15) >> 2)) * 64 + ((lq >> 4) & 1) * 32 + (lq & 3) * 8;
                const ALAS unsigned char* vb = lds + PR_V + ((it + 2) % 3) * 32768 + 4 * 512 + voff;
#pragma unroll
                for (int ks = 0; ks < 4; ++ks) pa[ks] = *(const ALAS bf16x8*)(pslot + ks * 1024);
                const float alpha = *aslot;
                asm volatile("s_waitcnt lgkmcnt(0)" ::: "memory");
                if (lane == 0) *flagp = (unsigned)it;
                asm volatile("" ::: "memory");
                ldV(fa, 0, vb); ldV(fb, 1, vb); ATT_FENCE();
                if (__any(alpha != 1.0f)) {
#pragma unroll
                    for (int db = 0; db < 4; ++db)
#pragma unroll
                        for (int r = 0; r < 16; ++r) o[db][r] *= alpha;
                }
                ATT_FENCE();
                mmV(fa, 0); ATT_FENCE(); ldV(fa, 2, vb); ATT_FENCE();
                mmV(fb, 1); ATT_FENCE(); ldV(fb, 3, vb); ATT_FENCE();
                mmV(fa, 2); ATT_FENCE(); mmV(fb, 3); ATT_FENCE();
            }
            asm volatile("s_waitcnt lgkmcnt(0)" ::: "memory");
        }
    }
    ALAS float* xs = (ALAS float*)(lds + PR_X) + pw * 64 + lane;
    float inv = 0.f;
    if (prod) { const float lt = lrun + __shfl_xor(lrun, 32); inv = 1.0f / lt; *xs = inv; }
    asm volatile("s_waitcnt vmcnt(0) lgkmcnt(0)" ::: "memory");
    __syncthreads();
    if (!prod) inv = *xs;
    return inv;
}
}

#define LAS __attribute__((address_space(3)))
typedef unsigned short bf16;
typedef float f32x4 __attribute__((ext_vector_type(4)));
typedef unsigned u32x4v __attribute__((ext_vector_type(4)));
typedef unsigned u32x2v __attribute__((ext_vector_type(2)));
constexpr int S = 16384, DM = 2048, FF = 5632;
constexpr int NTHREADS = 512, NWAVES = 8;
constexpr float EPS = 1e-6f;
constexpr int LDS_BYTES = 156672;
constexpr size_t MiB = 1u << 20;
constexpr size_t W_QKV = 0;
constexpr size_t W_DO = W_QKV + (size_t)6144 * 2048 * 2;
constexpr size_t W_DOWN = W_DO + (size_t)2048 * 2048 * 2;
constexpr size_t W_UQ = W_DOWN + (size_t)1280 * 2048 * 2;
constexpr size_t W_UKV = W_UQ + (size_t)3072 * 512 * 2;
constexpr size_t W_MO = W_UKV + (size_t)4096 * 512 * 2;
constexpr size_t W_FIN = W_MO + (size_t)2048 * 2048 * 2;
constexpr size_t W_FOUT = W_FIN + (size_t)2 * 11264 * 2048 * 2;
constexpr size_t W_END = W_FOUT + (size_t)2 * 2048 * 5632 * 2;
constexpr size_t WS_H = 192 * MiB;
constexpr size_t WS_C = 256 * MiB;
constexpr size_t WS_E = 480 * MiB;
constexpr size_t WS_G = 608 * MiB;
constexpr size_t WS_CQN = WS_G, WS_CKVN = WS_G + 16 * MiB, WS_KROPE = WS_G + 32 * MiB, WS_CS = WS_G + 34 * MiB, WS_POSF = WS_G + 38 * MiB;
constexpr size_t WS_KMAXT = WS_POSF + 640 * 1024, WS_PMAXT = WS_KMAXT + 16384, WS_PMINT = WS_PMAXT + 8192, WS_CTR = WS_PMINT + 8192;
constexpr size_t WS_BAR = WS_G + 38 * MiB + 768 * 1024;
constexpr size_t WS_END = WS_G + 39 * MiB;
static_assert(W_END <= WS_H, "weights fit");

struct Params {
    const float* x; const int* pos; const float* gains; const float* d_wqkv; const float* d_lam; const float* d_subln; const float* d_wo;
    const float* m_wdown; const float* m_qn; const float* m_kvn; const float* m_wuq; const float* m_wukv; const float* m_wo; const float* f_win; const float* f_wout;
    float* out; unsigned char* ws;
    float inv_freq[32];
    int ph_lo, ph_hi;
};

__device__ __forceinline__ unsigned f2bf(float f) { unsigned u = __builtin_bit_cast(unsigned, f); return (u + 0x7fffu + ((u >> 16) & 1u)) >> 16; }
__device__ __forceinline__ unsigned pk2(float lo, float hi) { return f2bf(lo) | (f2bf(hi) << 16); }
#define XB_TMO      128
#define XB_XCNT(j)  (256  + 64 * (j))
#define XB_XSUB(j)  (1280 + 64 * (j))
#define XB_XGEN(j)  (2304 + 64 * (j))
#define XB_TOP      3328
#define XB_TOPGEN   3392
#define XCD_BAR_WORDS 3456
#define XB_SPIN_CAP (1u << 18)

__device__ __forceinline__ unsigned xb_ld(unsigned* p)              { return __hip_atomic_load(p, __ATOMIC_RELAXED, __HIP_MEMORY_SCOPE_AGENT); }
__device__ __forceinline__ unsigned xb_add(unsigned* p, unsigned v) { return __hip_atomic_fetch_add(p, v, __ATOMIC_RELAXED, __HIP_MEMORY_SCOPE_AGENT); }
__device__ __forceinline__ unsigned xb_xcc_id() { return (unsigned)__builtin_amdgcn_s_getreg((3 << 11) | 20) & 0xFu; }
#define XB_SPIN(cond, bar) do { unsigned _sp = 0; while (cond) { __builtin_amdgcn_s_sleep(1); \
    if ((++_sp & 255u) == 0u) { if (xb_ld(&(bar)[XB_TMO])) break; if (_sp > XB_SPIN_CAP) { atomicAdd(&(bar)[XB_TMO], 1u); break; } } } } while (0)

struct XcdBarrier {
    unsigned* bar; unsigned x;
    volatile LAS unsigned* st;
};

__device__ __forceinline__ XcdBarrier xcd_barrier_post(unsigned* bar, volatile LAS unsigned* st) {
    XcdBarrier b; b.bar = bar; b.x = xb_xcc_id(); b.st = st;
    if (threadIdx.x == 0) (void)xb_add(&bar[XB_XCNT(b.x)], 1u);
    return b;
}
__device__ __forceinline__ void xcd_barrier_complete(unsigned* bar, unsigned x, unsigned& nloc, unsigned& nx) {
    const unsigned G = gridDim.x * gridDim.y * gridDim.z;
    unsigned sum, cnt, mine, sp = 0u;
    for (;;) {
        sum = 0u; cnt = 0u; mine = 0u;
#pragma unroll
        for (unsigned j = 0; j < 16; ++j) { const unsigned c = xb_ld(&bar[XB_XCNT(j)]); sum += c; cnt += (c > 0u) ? 1u : 0u; mine = (j == x) ? c : mine; }
        if (sum == G) break;
        __builtin_amdgcn_s_sleep(1);
        if ((++sp & 255u) == 0u) { if (xb_ld(&bar[XB_TMO])) break; if (sp > XB_SPIN_CAP) { atomicAdd(&bar[XB_TMO], 1u); break; } }
    }
    nloc = mine > 0u ? mine : 1u; nx = cnt > 0u ? cnt : 1u;
}

__device__ __forceinline__ void xcd_barrier(const XcdBarrier& b) {
    asm volatile("s_waitcnt vmcnt(0)" ::: "memory");
    __syncthreads();
    if (threadIdx.x == 0) {
        unsigned* bar = b.bar;
        __builtin_amdgcn_s_waitcnt(0);
        unsigned nloc = b.st[0], nx = b.st[1];
        if (nloc == 0u) { xcd_barrier_complete(bar, b.x, nloc, nx); b.st[0] = nloc; b.st[1] = nx; }
        const unsigned old = xb_add(&bar[XB_XSUB(b.x)], 1u);
        const unsigned gen = old / nloc;
        if (old + 1u == (gen + 1u) * nloc) {
            __builtin_amdgcn_fence(__ATOMIC_RELEASE, "agent");
            asm volatile("s_waitcnt vmcnt(0)" ::: "memory");
            const unsigned og = xb_add(&bar[XB_TOP], 1u);
            const unsigned tg = og / nx;
            if (og + 1u == (tg + 1u) * nx) xb_add(&bar[XB_TOPGEN], 1u);
            else XB_SPIN(xb_ld(&bar[XB_TOPGEN]) == tg, bar);
            __builtin_amdgcn_fence(__ATOMIC_ACQUIRE, "agent");
            xb_add(&bar[XB_XGEN(b.x)], 1u);
            asm volatile("s_waitcnt vmcnt(0)" ::: "memory");
        } else {
            XB_SPIN(xb_ld(&bar[XB_XGEN(b.x)]) == gen, bar);
            __builtin_amdgcn_fence(__ATOMIC_ACQUIRE, "agent");
            asm volatile("s_waitcnt vmcnt(0)" ::: "memory");
        }
    }
    __syncthreads();
}

__device__ __forceinline__ float wave_sum(float v) {
#pragma unroll
    for (int o = 1; o < 64; o <<= 1) v += __shfl_xor(v, o);
    return v;
}
__device__ __forceinline__ int dest_row(int mode, int n) {
    if (mode == 1) { const bool up = n >= FF; const int c = up ? n - FF : n; return (c >> 7) * 256 + (up ? 128 : 0) + (c & 127); }
    if (mode == 2) { const int head = n / 192, d = n % 192; if (d < 128) return head * 128 + d; const int i = d - 128; return 2048 + (head >> 2) * 256 + (i >> 5) * 128 + (head & 3) * 32 + (i & 31); }
    return n;
}
struct CvtItem { const float* W; bf16* WT; int K, N, mode, item; };
__device__ __forceinline__ void cvt_load(const CvtItem& c, int lane, f32x4 (&wv)[8]) {
    const int nblk = c.N / 32, kb = c.item / nblk, nb = c.item % nblk, k0 = 64 * kb, n0 = 32 * nb;
#pragma unroll
    for (int i = 0; i < 8; ++i) wv[i] = *(const f32x4*)(c.W + (size_t)(k0 + 8 * i + (lane >> 3)) * c.N + n0 + 4 * (lane & 7));
}
__device__ __forceinline__ void cvt_finish(const CvtItem& c, int lane, const f32x4 (&wv)[8], LAS float* scr) {
    const int nblk = c.N / 32, kb = c.item / nblk, nb = c.item % nblk, k0 = 64 * kb, n0 = 32 * nb;
#pragma unroll
    for (int i = 0; i < 8; ++i) { LAS float* d = scr + (8 * i + (lane >> 3)) * 33 + 4 * (lane & 7); d[0] = wv[i].x; d[1] = wv[i].y; d[2] = wv[i].z; d[3] = wv[i].w; }
    asm volatile("s_waitcnt lgkmcnt(0)" ::: "memory");
    const int cc = lane & 7;
#pragma unroll
    for (int j = 0; j < 4; ++j) { const int n = (lane >> 3) + 8 * j; const LAS float* s = scr + (8 * cc) * 33 + n;
        u32x4v o; o.x = pk2(s[0 * 33], s[1 * 33]); o.y = pk2(s[2 * 33], s[3 * 33]); o.z = pk2(s[4 * 33], s[5 * 33]); o.w = pk2(s[6 * 33], s[7 * 33]);
        *(u32x4v*)(c.WT + (size_t)dest_row(c.mode, n0 + n) * c.K + k0 + 8 * cc) = o; }
    asm volatile("s_waitcnt lgkmcnt(0)" ::: "memory");
}
__device__ __forceinline__ void load_row(const float* p, int lane, f32x4 (&v)[8]) {
#pragma unroll
    for (int j = 0; j < 8; ++j) v[j] = *((const f32x4*)p + 64 * j + lane);
}
__device__ __forceinline__ void load_row_bf16(const bf16* p, int lane, f32x4 (&v)[8]) {
#pragma unroll
    for (int j = 0; j < 8; ++j) { const u32x2v w = *((const u32x2v*)p + 64 * j + lane);
        v[j].x = __uint_as_float(w.x << 16); v[j].y = __uint_as_float(w.x & 0xffff0000u); v[j].z = __uint_as_float(w.y << 16); v[j].w = __uint_as_float(w.y & 0xffff0000u); }
}
__device__ __forceinline__ float sumsq_row(const f32x4 (&v)[8]) {
    float s = 0.f;
#pragma unroll
    for (int j = 0; j < 8; ++j) s += (v[j].x * v[j].x + v[j].y * v[j].y) + (v[j].z * v[j].z + v[j].w * v[j].w);
    return wave_sum(s);
}
__device__ __forceinline__ void norm_store_bf16(const f32x4 (&v)[8], const float* g, bf16* orow, int lane) {
    const float rs = 1.0f / sqrtf(sumsq_row(v) * (1.0f / DM) + EPS);
#pragma unroll
    for (int j = 0; j < 8; ++j) { const f32x4 gg = *((const f32x4*)g + 64 * j + lane); const f32x4 t = v[j] * rs * gg;
        u32x2v w; w.x = pk2(t.x, t.y); w.y = pk2(t.z, t.w); *((u32x2v*)orow + 64 * j + lane) = w; }
}
__device__ __forceinline__ void row_phase(const float* base, const bf16* y, const float* ga, const float* gb, float* xout, bf16* hbuf, int gw, int NGW, int lane) {
    for (int m = gw; m < S; m += NGW) {
        f32x4 v[8], xb[8];
        load_row_bf16(y + (size_t)m * DM, lane, v); load_row(base + (size_t)m * DM, lane, xb);
        const float rs = 1.0f / sqrtf(sumsq_row(v) * (1.0f / DM) + EPS);
#pragma unroll
        for (int j = 0; j < 8; ++j) { const f32x4 gg = *((const f32x4*)ga + 64 * j + lane); xb[j] = xb[j] + v[j] * rs * gg; *((f32x4*)(xout + (size_t)m * DM) + 64 * j + lane) = xb[j]; }
        if (gb) norm_store_bf16(xb, gb, hbuf + (size_t)m * DM, lane);
    }
}

template <class Epi>
__device__ __forceinline__ void run_gemm(LAS unsigned char* lds, const bf16* A, const bf16* Bt, int N, int K, const Epi& E) {
    pg8::Gemm g{A, Bt, S, N, K}; pg8::StaticOrder So; So.init(S, N, (int)gridDim.x, (int)blockIdx.x);
    pg8::gemm_phase<Epi, pg8::StaticOrder, true, true>(lds, g, So, E);
}

__global__ void __launch_bounds__(NTHREADS) fwd_mega(Params P) {
    extern __shared__ __attribute__((aligned(16))) unsigned char lds_raw[];
    LAS unsigned char* lds = (LAS unsigned char*)lds_raw;
    cg::grid_group grid = cg::this_grid();
    const int tid = threadIdx.x, lane = tid & 63, wave = __builtin_amdgcn_readfirstlane(tid >> 6);
    const int G = gridDim.x; const int bx = blockIdx.x; const int vcu = (G % 8 == 0) ? (bx % 8) * (G / 8) + bx / 8 : bx;
    const int gw = vcu * NWAVES + wave, NGW = G * NWAVES;
    unsigned char* ws = P.ws;
    bf16* Wqkv = (bf16*)(ws + W_QKV); bf16* Wdo = (bf16*)(ws + W_DO); bf16* Wdown = (bf16*)(ws + W_DOWN); bf16* Wuq = (bf16*)(ws + W_UQ); bf16* Wukv = (bf16*)(ws + W_UKV);
    bf16* Wmo = (bf16*)(ws + W_MO); bf16* Wfin = (bf16*)(ws + W_FIN); bf16* Wfout = (bf16*)(ws + W_FOUT);
    bf16* HB = (bf16*)(ws + WS_H); bf16* CB = (bf16*)(ws + WS_C); float* YB = (float*)(ws + WS_E); bf16* YH = (bf16*)(ws + WS_E);
    bf16* CQN = (bf16*)(ws + WS_CQN); bf16* CKVN = (bf16*)(ws + WS_CKVN); bf16* KROPE = (bf16*)(ws + WS_KROPE); float* CS = (float*)(ws + WS_CS); float* POSF = (float*)(ws + WS_POSF);
    volatile LAS unsigned* bst = (volatile LAS unsigned*)(lds + LDS_BYTES - 64);
    if (tid < 2) bst[tid] = 0u;
    __syncthreads();
    XcdBarrier xbar = xcd_barrier_post((unsigned*)(ws + WS_BAR), bst);
    const int lo = P.ph_lo, hi_ph = P.ph_hi;
#define IN(k) (lo <= (k) && (k) < hi_ph)
#define SEAM(k) do { if (IN(k) && IN((k) + 1)) xcd_barrier(xbar); } while (0)
    if (lo < 0) grid.sync();

    if (IN(0)) {
        LAS float* scr = (LAS float*)(lds + wave * 16384);
        constexpr int I_QKV = (2048 / 64) * (6144 / 32), I_DO = (2048 / 64) * (2048 / 32), I_DOWN = (2048 / 64) * (1088 / 32), I_UQ = (512 / 64) * (3072 / 32), I_UKV = (512 / 64) * (4096 / 32),
                      I_MO = I_DO, I_FIN = (2048 / 64) * (11264 / 32), I_FOUT = (5632 / 64) * (2048 / 32);
        constexpr int NITEMS = I_QKV + I_DO + I_DOWN + I_UQ + I_UKV + I_MO + 2 * I_FIN + 2 * I_FOUT;
        auto decode = [&](int it) -> CvtItem {
            int r = it;
            if (r < I_QKV) return CvtItem{P.d_wqkv, Wqkv, 2048, 6144, 0, r}; r -= I_QKV;
            if (r < I_DO) return CvtItem{P.d_wo, Wdo, 2048, 2048, 0, r}; r -= I_DO;
            if (r < I_DOWN) return CvtItem{P.m_wdown, Wdown, 2048, 1088, 0, r}; r -= I_DOWN;
            if (r < I_UQ) return CvtItem{P.m_wuq, Wuq, 512, 3072, 2, r}; r -= I_UQ;
            if (r < I_UKV) return CvtItem{P.m_wukv, Wukv, 512, 4096, 0, r}; r -= I_UKV;
            if (r < I_MO) return CvtItem{P.m_wo, Wmo, 2048, 2048, 0, r}; r -= I_MO;
            if (r < 2 * I_FIN) { const int l = r / I_FIN; return CvtItem{P.f_win + (size_t)l * 2048 * 11264, Wfin + (size_t)l * 11264 * 2048, 2048, 11264, 1, r % I_FIN}; } r -= 2 * I_FIN;
            { const int l = r / I_FOUT; return CvtItem{P.f_wout + (size_t)l * 5632 * 2048, Wfout + (size_t)l * 2048 * 5632, 5632, 2048, 0, r % I_FOUT}; }
        };
        if (gw < NITEMS) {
            f32x4 wa[8], wb[8];
            CvtItem cur = decode(gw); cvt_load(cur, lane, wa);
            for (int it = gw;;) {
                const int nx = it + NGW; const bool hn = nx < NITEMS;
                CvtItem nxt = cur;
                if (hn) { nxt = decode(nx); cvt_load(nxt, lane, wb); }
                cvt_finish(cur, lane, wa, scr);
                if (!hn) break;
#pragma unroll
                for (int i = 0; i < 8; ++i) wa[i] = wb[i];
                cur = nxt; it = nx;
            }
        }
        if (bx == 0 && tid == 0) *(unsigned*)(ws + WS_CTR) = 0u;
        for (int i = bx * NTHREADS + tid; i < (1280 - 1088) * 2048 / 8; i += G * NTHREADS) *((u32x4v*)(Wdown + (size_t)1088 * 2048) + i) = (u32x4v){0u, 0u, 0u, 0u};
        for (int i = bx * NTHREADS + tid; i < S; i += G * NTHREADS) { const float pf = (float)P.pos[i]; POSF[i] = pf;
#pragma unroll
            for (int h = 0; h < 8; ++h) POSF[(h + 1) * S + i] = pf * (11.313708498984761f * __builtin_amdgcn_exp2f(-(float)(h + 1))); }
        for (int m = gw; m < S; m += NGW) { f32x4 v[8]; load_row(P.x + (size_t)m * DM, lane, v); norm_store_bf16(v, P.gains, HB + (size_t)m * DM, lane); }
    }
    SEAM(0);
    if (IN(1)) { pg8::EpiQKV E{CB, CB + (size_t)16 * S * 128, CB + (size_t)32 * S * 128, S}; run_gemm(lds, HB, Wqkv, 6144, 2048, E);
        xcd_barrier(xbar);
        float* KMAXT = (float*)(ws + WS_KMAXT); float* PMAXT = (float*)(ws + WS_PMAXT); float* PMINT = (float*)(ws + WS_PMINT);
        const bf16* Kh = CB + (size_t)16 * S * 128;
        for (int task = gw; task < 16 * 256; task += NGW) {
            const u32x4v* kr = (const u32x4v*)(Kh + ((size_t)(task >> 8) * S + (size_t)(task & 255) * 64 + lane) * 128);
            float ssq = 0.f;
#pragma unroll
            for (int i = 0; i < 16; ++i) { const u32x4v w = kr[i];
#pragma unroll
                for (int j = 0; j < 4; ++j) { const float a = __uint_as_float(w[j] << 16), b = __uint_as_float(w[j] & 0xffff0000u); ssq += a * a + b * b; } }
#pragma unroll
            for (int o = 1; o < 64; o <<= 1) ssq = __builtin_fmaxf(ssq, __shfl_xor(ssq, o));
            if (lane == 0) KMAXT[task] = sqrtf(ssq) * 1.002f;
        }
        for (int task = gw; task < 8 * 256; task += NGW) {
            const float v = POSF[(size_t)((task >> 8) + 1) * S + (task & 255) * 64 + lane];
            float mx = v, mn = v;
#pragma unroll
            for (int o = 1; o < 64; o <<= 1) { mx = __builtin_fmaxf(mx, __shfl_xor(mx, o)); mn = __builtin_fminf(mn, __shfl_xor(mn, o)); }
            if (lane == 0) { PMAXT[task] = mx; PMINT[task] = mn; }
        }
    }
    SEAM(1);
    if (IN(2)) {
        _Float16* OX = (_Float16*)(ws + WS_E);
        const int r32 = lane & 31, hi = lane >> 5, pw = wave & 3, dvo = (wave >> 2) * 128;
        {
            unsigned* ctr = (unsigned*)(ws + WS_CTR);
            volatile LAS unsigned* ub = (volatile LAS unsigned*)(lds + att::PR_X + 2048);
            const float* KMAXT = (const float*)(ws + WS_KMAXT); const float* PMAXT = (const float*)(ws + WS_PMAXT); const float* PMINT = (const float*)(ws + WS_PMINT);
            for (;;) {
                if (tid == 0) *ub = atomicAdd(ctr, 1u);
                __syncthreads();
                const unsigned u = *ub;
                __syncthreads();
                if (u >= 2048u) break;
                const int head = 7 - (int)(u >> 8), qb = 127 - (int)((u & 255u) >> 1), sm = (int)(u & 1u), q0 = qb * 128;
                const int qidx = q0 + 32 * pw + r32;
                att::Args A; A.Q = CB + (size_t)(head * 2 + sm) * S * 128; A.qpitch = 128; A.K = CB + (size_t)16 * S * 128 + (size_t)(head * 2 + sm) * S * 128; A.kpitch = 128; A.K2 = nullptr; A.k2pitch = 0;
                A.V = CB + (size_t)32 * S * 128 + (size_t)head * S * 256; A.vpitch = 256; A.posf = POSF + (size_t)(head + 1) * S; A.c1 = 0.08838834764831845f * 1.4426950408889634f; A.slope2 = 0.f;
                A.kmaxt = KMAXT + (head * 2 + sm) * 256; A.pmaxt = PMAXT + head * 256; A.pmint = PMINT + head * 256;
                att::f32x16 o[4];
                const float inv = att::attn_diff_pair(lds, A, q0, o);
                _Float16* orow = OX + (size_t)sm * S * DM + (size_t)qidx * DM + head * 256 + dvo + 4 * hi;
#pragma unroll
                for (int db = 0; db < 4; ++db)
#pragma unroll
                    for (int g = 0; g < 4; ++g) {
                        typedef _Float16 h4 __attribute__((ext_vector_type(4)));
                        h4 w; w[0] = (_Float16)(o[db][4 * g] * inv); w[1] = (_Float16)(o[db][4 * g + 1] * inv); w[2] = (_Float16)(o[db][4 * g + 2] * inv); w[3] = (_Float16)(o[db][4 * g + 3] * inv);
                        *(h4*)(orow + 32 * db + 8 * g) = w; }
            }
        }
        xcd_barrier(xbar);
        {
            float lam_full;
            { const float* L = P.d_lam; const float a = L[lane] * L[128 + lane] + L[64 + lane] * L[192 + lane], b = L[256 + lane] * L[384 + lane] + L[320 + lane] * L[448 + lane];
              lam_full = __expf(wave_sum(a)) - __expf(wave_sum(b)) + 0.2f; }
            typedef _Float16 h4 __attribute__((ext_vector_type(4)));
            const f32x4 gg = *((const f32x4*)P.d_subln + lane);
            for (int it = gw; it < S * 8; it += NGW) {
                const size_t off = (size_t)it * 256 + lane * 4;
                const h4 a = *(const h4*)(OX + off), b = *(const h4*)(OX + (size_t)S * DM + off);
                f32x4 v; v.x = (float)a[0] - lam_full * (float)b[0]; v.y = (float)a[1] - lam_full * (float)b[1]; v.z = (float)a[2] - lam_full * (float)b[2]; v.w = (float)a[3] - lam_full * (float)b[3];
                const float ss = wave_sum((v.x * v.x + v.y * v.y) + (v.z * v.z + v.w * v.w));
                const float rs = 0.8f / sqrtf(ss * (1.0f / 256.0f) + EPS);
                u32x2v w; w.x = pk2(v.x * rs * gg.x, v.y * rs * gg.y); w.y = pk2(v.z * rs * gg.z, v.w * rs * gg.w);
                *(u32x2v*)(HB + off) = w;
            }
        }
    }
    SEAM(2);
    if (IN(3)) { pg8::EpiBf16 E{YH, DM}; run_gemm(lds, HB, Wdo, 2048, 2048, E); }
    SEAM(3);
    if (IN(4)) row_phase(P.x, YH, P.gains + 1 * DM, P.gains + 2 * DM, P.out, HB, gw, NGW, lane);
    SEAM(4);
    if (IN(5)) { pg8::EpiSwiGLU E{CB, FF}; run_gemm(lds, HB, Wfin, 11264, 2048, E); }
    SEAM(5);
    if (IN(6)) { pg8::EpiBf16 E{YH, DM}; run_gemm(lds, CB, Wfout, 2048, FF, E); }
    SEAM(6);
    if (IN(7)) row_phase(P.out, YH, P.gains + 3 * DM, P.gains + 4 * DM, P.out, HB, gw, NGW, lane);
    SEAM(7);
    if (IN(8)) { pg8::EpiF32 E{YB, 1280}; run_gemm(lds, HB, Wdown, 1280, 2048, E); }
    SEAM(8);
    if (IN(9)) {
        for (int m = gw; m < S; m += NGW) {
            const float* c = YB + (size_t)m * 1280;
#pragma unroll
            for (int part = 0; part < 2; ++part) {
                const f32x4 a = *((const f32x4*)(c + part * 512) + lane), b = *((const f32x4*)(c + part * 512) + 64 + lane);
                const float ss = wave_sum((a.x * a.x + a.y * a.y) + (a.z * a.z + a.w * a.w) + (b.x * b.x + b.y * b.y) + (b.z * b.z + b.w * b.w));
                const float rs = 1.0f / sqrtf(ss * (1.0f / 512.0f) + EPS);
                const float* gn = part == 0 ? P.m_qn : P.m_kvn; bf16* dst = (part == 0 ? CQN : CKVN) + (size_t)m * 512;
                const f32x4 ga = *((const f32x4*)gn + lane), gb = *((const f32x4*)gn + 64 + lane);
                u32x2v w; w.x = pk2(a.x * rs * ga.x, a.y * rs * ga.y); w.y = pk2(a.z * rs * ga.z, a.w * rs * ga.w); *((u32x2v*)dst + lane) = w;
                w.x = pk2(b.x * rs * gb.x, b.y * rs * gb.y); w.y = pk2(b.z * rs * gb.z, b.w * rs * gb.w); *((u32x2v*)dst + 64 + lane) = w;
            }
            if (lane < 32) {
                const float ang = POSF[m] * P.inv_freq[lane];
                const float cc = cosf(ang), sn = sinf(ang);
                const float x1 = c[1024 + lane], x2 = c[1056 + lane];
                KROPE[(size_t)m * 64 + lane] = (bf16)f2bf(x1 * cc - x2 * sn); KROPE[(size_t)m * 64 + 32 + lane] = (bf16)f2bf(x2 * cc + x1 * sn);
                CS[(size_t)m * 64 + lane] = cc; CS[(size_t)m * 64 + 32 + lane] = sn;
            }
        }
    }
    SEAM(9);
    bf16* QB2 = CB; bf16* KVB = CB + (size_t)S * 3072;
    if (IN(10)) {
        { pg8::EpiQRope E{QB2, CS}; run_gemm(lds, CQN, Wuq, 3072, 512, E); }
        { pg8::EpiBf16 E{KVB, 4096}; run_gemm(lds, CKVN, Wukv, 4096, 512, E); }
    }
    SEAM(10);
    if (IN(11)) {
        const int r32 = lane & 31, hi = lane >> 5;
        for (int pr = vcu; pr < 16 * 32; pr += G) {
            const int head = pr >> 5, sidx = pr & 31;
            for (int half = 0; half < 2; ++half) {
                const int qb = half == 0 ? 63 - sidx : sidx, q0 = qb * 256;
                const int qidx = q0 + 32 * wave + r32;
                att::Args A; A.Q = QB2 + head * 192; A.qpitch = 3072; A.K = KVB + head * 256; A.kpitch = 4096; A.K2 = KROPE; A.k2pitch = 64;
                A.V = KVB + head * 256 + 128; A.vpitch = 4096; A.posf = nullptr; A.c1 = 0.07216878364870323f * 1.4426950408889634f; A.slope2 = 0.f; A.kmaxt = nullptr; A.pmaxt = nullptr; A.pmint = nullptr;
                att::f32x16 o[4];
                const float inv = att::attn_mla_lag(lds, A, q0, o);
                bf16* orow = HB + (size_t)qidx * DM + head * 128 + 4 * hi;
#pragma unroll
                for (int db = 0; db < 4; ++db)
#pragma unroll
                    for (int g = 0; g < 4; ++g) { u32x2v w; w.x = pk2(o[db][4 * g] * inv, o[db][4 * g + 1] * inv); w.y = pk2(o[db][4 * g + 2] * inv, o[db][4 * g + 3] * inv);
                        *(u32x2v*)(orow + 32 * db + 8 * g) = w; }
            }
        }
    }
    SEAM(11);
    if (IN(12)) { pg8::EpiBf16 E{YH, DM}; run_gemm(lds, HB, Wmo, 2048, 2048, E); }
    SEAM(12);
    if (IN(13)) row_phase(P.out, YH, P.gains + 5 * DM, P.gains + 6 * DM, P.out, HB, gw, NGW, lane);
    SEAM(13);
    if (IN(14)) { pg8::EpiSwiGLU E{CB, FF}; run_gemm(lds, HB, Wfin + (size_t)11264 * 2048, 11264, 2048, E); }
    SEAM(14);
    if (IN(15)) { pg8::EpiBf16 E{YH, DM}; run_gemm(lds, CB, Wfout + (size_t)2048 * 5632, 2048, FF, E); }
    SEAM(15);
    if (IN(16)) row_phase(P.out, YH, P.gains + 7 * DM, nullptr, P.out, nullptr, gw, NGW, lane);
#undef IN
#undef SEAM
}

constexpr int N_PHASES = 17;
#ifndef MK_MULTI
#define MK_MULTI 0
#endif
extern "C" void kernel_launch(void* const* d_in, const int* in_sizes, int n_in, void* d_out, int out_size, void* d_ws, size_t ws_size, hipStream_t stream) {
    static int grid = 0;
    if (grid == 0) {
        if (n_in != 15 || in_sizes[0] != S * DM || out_size != S * DM || ws_size < WS_END) { fprintf(stderr, "kernel_launch: unexpected shapes / workspace (n_in %d, in0 %d, out %d, ws %zu < %zu)\n", n_in, n_in > 0 ? in_sizes[0] : -1, out_size, ws_size, (size_t)WS_END); grid = -1; return; }
        int dev = 0, cus = 0, per_cu = 0;
        hipGetDevice(&dev); hipDeviceGetAttribute(&cus, hipDeviceAttributeMultiprocessorCount, dev);
        if (hipFuncSetAttribute((const void*)fwd_mega, hipFuncAttributeMaxDynamicSharedMemorySize, LDS_BYTES) != hipSuccess) { fprintf(stderr, "kernel_launch: hipFuncSetAttribute failed\n"); grid = -1; return; }
        if (hipOccupancyMaxActiveBlocksPerMultiprocessor(&per_cu, (const void*)fwd_mega, NTHREADS, LDS_BYTES) != hipSuccess || per_cu < 1) { fprintf(stderr, "kernel_launch: occupancy query gave %d\n", per_cu); per_cu = 1; (void)hipGetLastError(); }
        grid = cus * 1;
    }
    if (grid < 0) return;
    if (hipMemsetAsync((char*)d_ws + WS_BAR, 0, XCD_BAR_WORDS * 4, stream) != hipSuccess) { fprintf(stderr, "kernel_launch: hipMemsetAsync of the barrier words failed\n"); return; }
    Params p; memset(&p, 0, sizeof(p));
    p.x = (const float*)d_in[0]; p.pos = (const int*)d_in[1]; p.gains = (const float*)d_in[2]; p.d_wqkv = (const float*)d_in[3]; p.d_lam = (const float*)d_in[4]; p.d_subln = (const float*)d_in[5];
    p.d_wo = (const float*)d_in[6]; p.m_wdown = (const float*)d_in[7]; p.m_qn = (const float*)d_in[8]; p.m_kvn = (const float*)d_in[9]; p.m_wuq = (const float*)d_in[10]; p.m_wukv = (const float*)d_in[11];
    p.m_wo = (const float*)d_in[12]; p.f_win = (const float*)d_in[13]; p.f_wout = (const float*)d_in[14]; p.out = (float*)d_out; p.ws = (unsigned char*)d_ws;
    for (int i = 0; i < 32; ++i) p.inv_freq[i] = (float)pow(10000.0, -(double)(2 * i) / 64.0);
#if MK_MULTI
    for (int ph = 0; ph < N_PHASES; ++ph) { p.ph_lo = ph; p.ph_hi = ph + 1; void* args[] = {&p};
        hipError_t e = hipLaunchCooperativeKernel((const void*)fwd_mega, dim3(grid), dim3(NTHREADS), args, LDS_BYTES, stream);
        if (e != hipSuccess) { fprintf(stderr, "cooperative launch failed: %s\n", hipGetErrorString(e)); return; } }
#else
    p.ph_lo = 0; p.ph_hi = N_PHASES; void* args[] = {&p};
    hipError_t e = hipLaunchCooperativeKernel((const void*)fwd_mega, dim3(grid), dim3(NTHREADS), args, LDS_BYTES, stream);
    if (e != hipSuccess) fprintf(stderr, "cooperative launch failed: %s (grid %d)\n", hipGetErrorString(e), grid);
#endif
}
```

```cpp
#include <hip/hip_runtime.h>
#include <hip/hip_cooperative_groups.h>
#include <cstdio>
#include <cstdint>
#include <cmath>
#include <cstring>
namespace cg = cooperative_groups;

namespace pg8 {
#define PG8_LAS __attribute__((address_space(3)))
typedef unsigned short bf16_t;
typedef short bf16x8 __attribute__((ext_vector_type(8)));
typedef float f32x4 __attribute__((ext_vector_type(4)));
typedef unsigned u32x4 __attribute__((ext_vector_type(4)));
constexpr int BM = 256, BK = 64, HALF = 128, HTB = HALF * BK * 2  , STAGE_BYTES = 8 * HTB, NXCD = 8, WGM = 8;

__host__ __device__ __forceinline__ int lds_byte(int r, int c) { const int st = (r >> 4) * 2 + (c >> 5), rr = r & 15, cc = c & 31, ob = rr * 64 + cc * 2; return st * 1024 + (ob ^ (((ob >> 9) & 1) << 5)); }
__host__ __device__ __forceinline__ void stage_rc(int b, int& R, int& C) { const int st = b / 1024, sb = b % 1024, swz = sb ^ (((sb >> 9) & 1) << 5); R = (st >> 1) * 16 + swz / 64; C = (st & 1) * 32 + (swz % 64) / 2; }
__host__ __device__ __forceinline__ int perm32(int rho) { const int n = rho >> 4, i = rho & 15; return 8 * (i >> 2) + 4 * n + (i & 3); }

struct Unit { int pm, pn; };
struct Gemm { const bf16_t* A; const bf16_t* Bt; int M, N, K; };

struct StaticOrder {
    int nM, nN, nwg, G, c;
    __host__ __device__ void init(int M, int N, int G_, int c_) { nM = M / BM; nN = N / BM; nwg = nM * nN; G = G_; c = c_; }
    __host__ __device__ bool next(int i, Unit& u) const {
        const long L = (long)i * G + c; if (L >= nwg) return false;
        int wgid = (int)L; { const int q = nwg / NXCD, r = nwg % NXCD, xcd = wgid % NXCD, off = wgid / NXCD; wgid = (xcd < r ? xcd * (q + 1) : r * (q + 1) + (xcd - r) * q) + off; }
        const int nig = WGM * nN, gid = wgid / nig, fm = gid * WGM, gsz = (nM - fm) < WGM ? (nM - fm) : WGM;
        u.pm = fm + ((wgid % nig) % gsz); u.pn = (wgid % nig) / gsz; return true;
    }
    __device__ __forceinline__ void a_ready(const Unit&) const {}
    __device__ __forceinline__ void done(const Unit&) const {}
};

__device__ __forceinline__ unsigned cvt_pk_bf16(float lo, float hi) { unsigned r; asm volatile("v_cvt_pk_bf16_f32 %0, %1, %2" : "=v"(r) : "v"(lo), "v"(hi)); return r; }

struct EpiBf16 {
    static constexpr bool PERM = true, AFTER_DRAIN = false;
    bf16_t* O; int ldc;
    __device__ __forceinline__ void operator()(const f32x4 (&acc)[2][2][4][2], const Unit& u, int wr, int wc, int fr, int fq) const {
        const int row0 = u.pm * BM + wr * 64 + fr; const int col0 = u.pn * BM + wc * 32 + 8 * fq;
#pragma unroll
        for (int ai = 0; ai < 2; ++ai)
#pragma unroll
            for (int m = 0; m < 4; ++m) { bf16_t* rowp = O + (size_t)(row0 + ai * HALF + m * 16) * ldc + col0;
#pragma unroll
                for (int bj = 0; bj < 2; ++bj) { const f32x4 v0 = acc[ai][bj][m][0], v1 = acc[ai][bj][m][1];
                    u32x4 w; w.x = cvt_pk_bf16(v0[0], v0[1]); w.y = cvt_pk_bf16(v0[2], v0[3]); w.z = cvt_pk_bf16(v1[0], v1[1]); w.w = cvt_pk_bf16(v1[2], v1[3]);
                    *(u32x4*)(rowp + bj * HALF) = w; } }
    }
};
struct EpiQKV {
    static constexpr bool PERM = true, AFTER_DRAIN = false;
    bf16_t* Qh; bf16_t* Kh; bf16_t* Vh; int M;
    __device__ __forceinline__ void operator()(const f32x4 (&acc)[2][2][4][2], const Unit& u, int wr, int wc, int fr, int fq) const {
        const int row0 = u.pm * BM + wr * 64 + fr; const int part = u.pn >> 3, head = u.pn & 7;
        bf16_t* base; size_t bjs; int pitch;
        if (part < 2) { base = (part == 0 ? Qh : Kh) + (size_t)(head * 2) * M * 128; bjs = (size_t)M * 128; pitch = 128; }
        else { base = Vh + (size_t)head * M * 256; bjs = 128; pitch = 256; }
#pragma unroll
        for (int ai = 0; ai < 2; ++ai)
#pragma unroll
            for (int m = 0; m < 4; ++m) { bf16_t* rowp = base + (size_t)(row0 + ai * HALF + m * 16) * pitch + wc * 32 + 8 * fq;
#pragma unroll
                for (int bj = 0; bj < 2; ++bj) { const f32x4 v0 = acc[ai][bj][m][0], v1 = acc[ai][bj][m][1];
                    u32x4 w; w.x = cvt_pk_bf16(v0[0], v0[1]); w.y = cvt_pk_bf16(v0[2], v0[3]); w.z = cvt_pk_bf16(v1[0], v1[1]); w.w = cvt_pk_bf16(v1[2], v1[3]);
                    *(u32x4*)(rowp + bj * bjs) = w; } }
    }
};
struct EpiF32 {
    static constexpr bool PERM = false, AFTER_DRAIN = false;
    float* O; int ldc;
    __device__ __forceinline__ void operator()(const f32x4 (&acc)[2][2][4][2], const Unit& u, int wr, int wc, int fr, int fq) const {
        const int row0 = u.pm * BM + wr * 64 + fr; const int col0 = u.pn * BM + wc * 32 + 4 * fq;
#pragma unroll
        for (int ai = 0; ai < 2; ++ai)
#pragma unroll
            for (int m = 0; m < 4; ++m) { float* rowp = O + (size_t)(row0 + ai * HALF + m * 16) * ldc + col0;
#pragma unroll
                for (int bj = 0; bj < 2; ++bj)
#pragma unroll
                    for (int n = 0; n < 2; ++n) *(f32x4*)(rowp + bj * HALF + n * 16) = acc[ai][bj][m][n]; }
    }
};
__device__ __forceinline__ float silu_mul(float g, float u) { return g * u * __builtin_amdgcn_rcpf(1.0f + __builtin_amdgcn_exp2f(-1.4426950408889634f * g)); }
struct EpiSwiGLU {
    static constexpr bool PERM = true, AFTER_DRAIN = false;
    bf16_t* O; int ldc;
    __device__ __forceinline__ void operator()(const f32x4 (&acc)[2][2][4][2], const Unit& u, int wr, int wc, int fr, int fq) const {
        const int row0 = u.pm * BM + wr * 64 + fr; const int col0 = u.pn * HALF + wc * 32 + 8 * fq;
#pragma unroll
        for (int ai = 0; ai < 2; ++ai)
#pragma unroll
            for (int m = 0; m < 4; ++m) { bf16_t* rowp = O + (size_t)(row0 + ai * HALF + m * 16) * ldc + col0;
                const f32x4 g0 = acc[ai][0][m][0], g1 = acc[ai][0][m][1], u0 = acc[ai][1][m][0], u1 = acc[ai][1][m][1];
                u32x4 w; w.x = cvt_pk_bf16(silu_mul(g0[0], u0[0]), silu_mul(g0[1], u0[1])); w.y = cvt_pk_bf16(silu_mul(g0[2], u0[2]), silu_mul(g0[3], u0[3]));
                w.z = cvt_pk_bf16(silu_mul(g1[0], u1[0]), silu_mul(g1[1], u1[1])); w.w = cvt_pk_bf16(silu_mul(g1[2], u1[2]), silu_mul(g1[3], u1[3]));
                *(u32x4*)rowp = w; }
    }
};
struct EpiQRope {
    static constexpr bool PERM = true, AFTER_DRAIN = false;
    bf16_t* O; const float* cs;
    __device__ __forceinline__ void operator()(const f32x4 (&acc)[2][2][4][2], const Unit& u, int wr, int wc, int fr, int fq) const {
        const int row0 = u.pm * BM + wr * 64 + fr;
        if (u.pn < 8) {
#pragma unroll
            for (int ai = 0; ai < 2; ++ai)
#pragma unroll
                for (int m = 0; m < 4; ++m) { bf16_t* rowp = O + (size_t)(row0 + ai * HALF + m * 16) * 3072 + wc * 32 + 8 * fq;
#pragma unroll
                    for (int bj = 0; bj < 2; ++bj) { const f32x4 v0 = acc[ai][bj][m][0], v1 = acc[ai][bj][m][1];
                        u32x4 w; w.x = cvt_pk_bf16(v0[0], v0[1]); w.y = cvt_pk_bf16(v0[2], v0[3]); w.z = cvt_pk_bf16(v1[0], v1[1]); w.w = cvt_pk_bf16(v1[2], v1[3]);
                        *(u32x4*)(rowp + (2 * u.pn + bj) * 192) = w; } }
        } else {
            const int head = 4 * (u.pn - 8) + wc;
#pragma unroll
            for (int ai = 0; ai < 2; ++ai)
#pragma unroll
                for (int m = 0; m < 4; ++m) { const int row = row0 + ai * HALF + m * 16; bf16_t* rowp = O + (size_t)row * 3072 + head * 192 + 128 + 8 * fq;
                    const float* cp = cs + (size_t)row * 64 + 8 * fq;
                    const f32x4 c0 = *(const f32x4*)cp, c1 = *(const f32x4*)(cp + 4), s0 = *(const f32x4*)(cp + 32), s1 = *(const f32x4*)(cp + 36);
                    const f32x4 a0 = acc[ai][0][m][0], a1 = acc[ai][0][m][1], b0 = acc[ai][1][m][0], b1 = acc[ai][1][m][1];
                    const f32x4 o10 = a0 * c0 - b0 * s0, o11 = a1 * c1 - b1 * s1, o20 = b0 * c0 + a0 * s0, o21 = b1 * c1 + a1 * s1;
                    u32x4 w; w.x = cvt_pk_bf16(o10[0], o10[1]); w.y = cvt_pk_bf16(o10[2], o10[3]); w.z = cvt_pk_bf16(o11[0], o11[1]); w.w = cvt_pk_bf16(o11[2], o11[3]);
                    *(u32x4*)rowp = w;
                    w.x = cvt_pk_bf16(o20[0], o20[1]); w.y = cvt_pk_bf16(o20[2], o20[3]); w.z = cvt_pk_bf16(o21[0], o21[1]); w.w = cvt_pk_bf16(o21[2], o21[3]);
                    *(u32x4*)(rowp + 32) = w; }
        }
    }
};

template <class Epi, class Sched, bool ALIGN_EPI = false, bool SP2 = false>
__device__ __forceinline__ void gemm_phase(PG8_LAS unsigned char* lds, const Gemm g, const Sched& S, const Epi& E) {
    const int tid = threadIdx.x, wid = __builtin_amdgcn_readfirstlane(tid >> 6), lane = tid & 63, wr = wid >> 2, wc = wid & 3, fr = lane & 15, fq = lane >> 4;
    const int K = g.K, nt = K / BK;
    unsigned voffA[2], voffB[2];
#pragma unroll
    for (int i = 0; i < 2; ++i) { int R, C; stage_rc(tid * 16 + i * 8192, R, C); const int Rb = Epi::PERM ? ((R & ~31) + perm32(R & 31)) : R;
        voffA[i] = (unsigned)(R * K + C) * 2u; voffB[i] = (unsigned)(Rb * K + C) * 2u; }
    const size_t kstep = (size_t)(BK * 2);
    const size_t hstep = (size_t)HALF * K * 2;
    const size_t tstep = 2 * hstep;
    const unsigned ldsw = (unsigned)wid * 1024u;
    const int aoff = lds_byte(wr * 64 + fr, fq * 8), boff = lds_byte(wc * 32 + fr, fq * 8);
#define PG8_SA(b, h) (((b) * 2 + (h)) * HTB)
#define PG8_SB(b, h) ((4 + (b) * 2 + (h)) * HTB)
#define PG8_STAGE(bufoff, gbase, voff) do { _Pragma("unroll") for (int _i = 0; _i < 2; ++_i) \
        __builtin_amdgcn_global_load_lds((const unsigned*)((const char*)(gbase) + (voff)[_i]), (PG8_LAS unsigned*)(lds + (bufoff) + ldsw + _i * 8192), 16, 0, 0); } while (0)
#define PG8_LDA(dst, b, h) do { _Pragma("unroll") for (int m = 0; m < 4; ++m) _Pragma("unroll") for (int k = 0; k < 2; ++k) dst[m][k] = *(const PG8_LAS bf16x8*)(lds + PG8_SA(b, h) + aoff + m * 2048 + k * 1024); } while (0)
#define PG8_LDB(dst, b, h) do { _Pragma("unroll") for (int n = 0; n < 2; ++n) _Pragma("unroll") for (int k = 0; k < 2; ++k) dst[n][k] = *(const PG8_LAS bf16x8*)(lds + PG8_SB(b, h) + boff + n * 2048 + k * 1024); } while (0)
#define PG8_MMA(ai, bj, At, Bt) do { __builtin_amdgcn_s_setprio(1); _Pragma("unroll") for (int m = 0; m < 4; ++m) _Pragma("unroll") for (int n = 0; n < 2; ++n) _Pragma("unroll") for (int k = 0; k < 2; ++k) \
        acc[ai][bj][m][n] = __builtin_amdgcn_mfma_f32_16x16x32_bf16(Bt[n][k], At[m][k], acc[ai][bj][m][n], 0, 0, 0); __builtin_amdgcn_s_setprio(0); } while (0)
#define PG8_WAIT_V(n) asm volatile("s_waitcnt vmcnt(" #n ")" ::: "memory")
#define PG8_WAIT_L(n) asm volatile("s_waitcnt lgkmcnt(" #n ")" ::: "memory")
#define PG8_BAR __builtin_amdgcn_s_barrier()
#define PG8_SCHED __builtin_amdgcn_sched_barrier(0)
    Unit cur, nxt; int ui = 0;
    if (!S.next(0, cur)) return;
    f32x4 acc[2][2][4][2];
#pragma unroll
    for (int a = 0; a < 2; ++a)
#pragma unroll
        for (int b = 0; b < 2; ++b)
#pragma unroll
            for (int m = 0; m < 4; ++m)
#pragma unroll
                for (int n = 0; n < 2; ++n) acc[a][b][m][n] = (f32x4){0.f, 0.f, 0.f, 0.f};
    bf16x8 At[4][2], B0[2][2], B1[2][2];
    const char* cA = (const char*)g.A + (size_t)cur.pm * tstep; const char* cB = (const char*)g.Bt + (size_t)cur.pn * tstep;
    S.a_ready(cur);
    if constexpr (SP2) {
        PG8_STAGE(PG8_SB(0, 0), cB, voffB); PG8_STAGE(PG8_SB(0, 1), cB + hstep, voffB); PG8_STAGE(PG8_SA(0, 0), cA, voffA); PG8_STAGE(PG8_SA(0, 1), cA + hstep, voffA);
        if (wr == 1) PG8_BAR;
        PG8_WAIT_V(2); PG8_BAR;
        PG8_STAGE(PG8_SB(1, 0), cB + kstep, voffB); PG8_STAGE(PG8_SA(1, 0), cA + kstep, voffA); PG8_STAGE(PG8_SB(1, 1), cB + hstep + kstep, voffB);
        PG8_WAIT_V(6); PG8_BAR;
    } else {
        PG8_STAGE(PG8_SB(0, 0), cB, voffB); PG8_STAGE(PG8_SA(0, 0), cA, voffA); PG8_STAGE(PG8_SB(0, 1), cB + hstep, voffB); PG8_STAGE(PG8_SA(0, 1), cA + hstep, voffA);
        if (wr == 1) PG8_BAR;
        PG8_WAIT_V(4); PG8_BAR;
        PG8_STAGE(PG8_SB(1, 0), cB + kstep, voffB); PG8_STAGE(PG8_SA(1, 0), cA + kstep, voffA); PG8_STAGE(PG8_SB(1, 1), cB + hstep + kstep, voffB);
        PG8_WAIT_V(6); PG8_BAR;
    }
    for (;;) {
        const bool has_next = S.next(ui + 1, nxt);
        const char* nA = has_next ? (const char*)g.A + (size_t)nxt.pm * tstep : cA; const char* nB = has_next ? (const char*)g.Bt + (size_t)nxt.pn * tstep : cB;
        for (int t = 0; t < nt; t += 2) {
            const bool last = (t == nt - 2);
            const char* a1 = cA + (size_t)(t + 1) * kstep;
            const char* a2 = last ? nA : cA + (size_t)(t + 2) * kstep; const char* b2 = last ? nB : cB + (size_t)(t + 2) * kstep;
            const char* a3 = a2 + kstep; const char* b3 = b2 + kstep;
            if (last && has_next) S.a_ready(nxt);
            if constexpr (SP2) {
            PG8_LDB(B0, 0, 0); PG8_LDB(B1, 0, 1); PG8_SCHED; PG8_LDA(At, 0, 0); PG8_STAGE(PG8_SA(1, 1), a1 + hstep, voffA);
            PG8_WAIT_V(8); PG8_WAIT_L(0); PG8_BAR; PG8_MMA(0, 0, At, B0); PG8_MMA(0, 1, At, B1); PG8_BAR; PG8_SCHED;
            PG8_LDA(At, 0, 1); PG8_STAGE(PG8_SB(0, 0), b2, voffB); PG8_STAGE(PG8_SB(0, 1), b2 + hstep, voffB); PG8_STAGE(PG8_SA(0, 0), a2, voffA);
            PG8_WAIT_V(8); PG8_WAIT_L(0); PG8_BAR; PG8_MMA(1, 0, At, B0); PG8_MMA(1, 1, At, B1); PG8_BAR; PG8_SCHED;
            PG8_LDB(B0, 1, 0); PG8_LDB(B1, 1, 1); PG8_SCHED; PG8_LDA(At, 1, 0); PG8_STAGE(PG8_SA(0, 1), a2 + hstep, voffA);
            PG8_WAIT_V(8); PG8_WAIT_L(0); PG8_BAR; PG8_MMA(0, 0, At, B0); PG8_MMA(0, 1, At, B1); PG8_BAR; PG8_SCHED;
            PG8_LDA(At, 1, 1); PG8_STAGE(PG8_SB(1, 0), b3, voffB); PG8_STAGE(PG8_SB(1, 1), b3 + hstep, voffB); PG8_STAGE(PG8_SA(1, 0), a3, voffA);
            PG8_WAIT_V(8); PG8_WAIT_L(0); PG8_BAR; PG8_MMA(1, 0, At, B0); PG8_MMA(1, 1, At, B1); PG8_BAR; PG8_SCHED;
            } else {
            PG8_LDB(B0, 0, 0); PG8_SCHED; PG8_LDA(At, 0, 0); PG8_STAGE(PG8_SA(1, 1), a1 + hstep, voffA);
            PG8_WAIT_L(8); PG8_BAR; PG8_WAIT_L(0); PG8_MMA(0, 0, At, B0); PG8_BAR; PG8_SCHED;
            PG8_LDB(B1, 0, 1); PG8_STAGE(PG8_SB(0, 0), b2, voffB);
            PG8_BAR; PG8_WAIT_L(0); PG8_MMA(0, 1, At, B1); PG8_BAR;
            PG8_LDA(At, 0, 1); PG8_STAGE(PG8_SA(0, 0), a2, voffA);
            PG8_BAR; PG8_WAIT_L(0); PG8_MMA(1, 0, At, B0); PG8_BAR; PG8_SCHED;
            PG8_STAGE(PG8_SB(0, 1), b2 + hstep, voffB);
            PG8_WAIT_V(6); PG8_BAR; PG8_MMA(1, 1, At, B1); PG8_BAR;
            PG8_LDB(B0, 1, 0); PG8_SCHED; PG8_LDA(At, 1, 0); PG8_STAGE(PG8_SA(0, 1), a2 + hstep, voffA);
            PG8_WAIT_L(8); PG8_BAR; PG8_WAIT_L(0); PG8_MMA(0, 0, At, B0); PG8_BAR; PG8_SCHED;
            PG8_LDB(B1, 1, 1); PG8_STAGE(PG8_SB(1, 0), b3, voffB);
            PG8_BAR; PG8_WAIT_L(0); PG8_MMA(0, 1, At, B1); PG8_BAR;
            PG8_LDA(At, 1, 1); PG8_STAGE(PG8_SA(1, 0), a3, voffA);
            PG8_BAR; PG8_WAIT_L(0); PG8_MMA(1, 0, At, B0); PG8_BAR; PG8_SCHED;
            PG8_STAGE(PG8_SB(1, 1), b3 + hstep, voffB);
            PG8_WAIT_V(6); PG8_BAR; PG8_MMA(1, 1, At, B1); PG8_BAR;
            }
        }
        if constexpr (ALIGN_EPI) { if (wr == 0) PG8_BAR; }
        if constexpr (!Epi::AFTER_DRAIN) { E(acc, cur, wr, wc, fr, fq); S.done(cur); }
        if (!has_next) break;
#pragma unroll
        for (int a = 0; a < 2; ++a)
#pragma unroll
            for (int b = 0; b < 2; ++b)
#pragma unroll
                for (int m = 0; m < 4; ++m)
#pragma unroll
                    for (int n = 0; n < 2; ++n) acc[a][b][m][n] = (f32x4){0.f, 0.f, 0.f, 0.f};
        cur = nxt; cA = nA; cB = nB; ++ui;
        if constexpr (ALIGN_EPI) { if (wr == 1) PG8_BAR; }
    }
    PG8_WAIT_V(0);
    if constexpr (!ALIGN_EPI) { if (wr == 0) PG8_BAR; }
    PG8_BAR;
    if constexpr (Epi::AFTER_DRAIN) { E.fused(acc, cur, wr, wc, fr, fq, lds, wid, lane); S.done(cur); }
#undef PG8_SA
#undef PG8_SB
#undef PG8_STAGE
#undef PG8_LDA
#undef PG8_LDB
#undef PG8_MMA
#undef PG8_WAIT_V
#undef PG8_WAIT_L
#undef PG8_BAR
#undef PG8_SCHED
}
}

namespace att {
#define ALAS __attribute__((address_space(3)))
typedef unsigned short bf16_t;
typedef short bf16x8 __attribute__((ext_vector_type(8)));
typedef short s16x4 __attribute__((ext_vector_type(4)));
typedef float f32x16 __attribute__((ext_vector_type(16)));
typedef float f32x4 __attribute__((ext_vector_type(4)));
typedef unsigned u32x4 __attribute__((ext_vector_type(4)));
typedef unsigned u32x2 __attribute__((ext_vector_type(2)));
__device__ __forceinline__ int crow(int r, int hi) { return (r & 3) + 8 * (r >> 2) + 4 * hi; }
__device__ __forceinline__ unsigned cvtpk(float lo, float hi) { unsigned r; asm volatile("v_cvt_pk_bf16_f32 %0, %1, %2" : "=v"(r) : "v"(lo), "v"(hi)); return r; }
__device__ __forceinline__ s16x4 vtr(const ALAS unsigned char* p) { return __builtin_bit_cast(s16x4, __builtin_amdgcn_ds_read_tr16_b64_v4i16((ALAS s16x4*)p)); }

typedef float f32x2 __attribute__((ext_vector_type(2)));
__device__ __forceinline__ float max3f(float a, float b, float c) { float r; asm("v_max3_f32 %0, %1, %2, %3" : "=v"(r) : "v"(a), "v"(b), "v"(c)); return r; }
__device__ __forceinline__ float rowmax32(const f32x16& p0, const f32x16& p1) {
    float a = max3f(p0[0], p0[1], p1[0]), b = max3f(p0[2], p0[3], p1[1]); a = max3f(a, p1[2], p1[3]);
#pragma unroll
    for (int r = 4; r < 16; r += 4) { a = max3f(a, p0[r], p0[r + 1]); b = max3f(b, p0[r + 2], p0[r + 3]); a = max3f(a, p1[r], p1[r + 1]); b = max3f(b, p1[r + 2], p1[r + 3]); }
    return max3f(a, b, b);
}
__device__ __forceinline__ float exp_sum32(f32x16& p0, f32x16& p1, float c1, float nm) {
    f32x2 acc = {0.f, 0.f};
#pragma unroll
    for (int r = 0; r < 16; r += 2) {
        f32x2 a = (f32x2){p0[r], p0[r + 1]} * c1 + nm, b = (f32x2){p1[r], p1[r + 1]} * c1 + nm;
        a.x = __builtin_amdgcn_exp2f(a.x); a.y = __builtin_amdgcn_exp2f(a.y); b.x = __builtin_amdgcn_exp2f(b.x); b.y = __builtin_amdgcn_exp2f(b.y);
        p0[r] = a.x; p0[r + 1] = a.y; p1[r] = b.x; p1[r + 1] = b.y; acc += a; acc += b;
    }
    return acc.x + acc.y;
}
__device__ __forceinline__ void glds16(const void* gsrc, unsigned lds_dst) { unsigned keep;
    asm volatile("s_mov_b32 %0, m0\n\ts_mov_b32 m0, %2\n\ts_nop 0\n\tglobal_load_lds_dwordx4 %1, off\n\ts_mov_b32 m0, %0" : "=&s"(keep) : "v"(gsrc), "s"(lds_dst) : "memory"); }
template <int MODE> struct Cfg;
template <> struct Cfg<0> { static constexpr int DQK = 128, DV = 128; };
template <> struct Cfg<1> { static constexpr int DQK = 192, DV = 128; };

struct Args {
    const bf16_t* Q; int qpitch;
    const bf16_t* K; int kpitch;
    const bf16_t* K2; int k2pitch;
    const bf16_t* V; int vpitch;
    const float* posf;
    float c1, slope2;
    const float* kmaxt; const float* pmaxt; const float* pmint;
};

#define ATT_WAITV(n) asm volatile("s_waitcnt vmcnt(" #n ")" ::: "memory")
template <int MODE>
__device__ __forceinline__ float attn_run(ALAS unsigned char* lds, const Args& A, int q0, f32x16 (&o)[Cfg<MODE>::DV / 32]) {
    constexpr int DQK = Cfg<MODE>::DQK, DV = Cfg<MODE>::DV, NKB = DQK / 64, NDB = DV / 32, NSTEP = DQK / 16;
    constexpr int KBYTES = 64 * DQK * 2, VBYTES = 64 * DV * 2, KOFF = 0, VOFF = 2 * KBYTES, POSOFF = 2 * KBYTES + 3 * VBYTES;
    constexpr int VBATCH = VBYTES / 8192;
    static_assert(POSOFF + 512 <= 131072 + 2048, "attention LDS");
    const int tid = threadIdx.x, lane = tid & 63, r32 = lane & 31, hi = lane >> 5; const int wid = __builtin_amdgcn_readfirstlane(tid >> 6);
    const int grp = wid >> 2;
    const int qrow0 = q0 + 32 * wid, qidx = qrow0 + r32;
    const int NT = (q0 + 256) / 64;
    bf16x8 qr[NSTEP];
    { const bf16_t* qp = A.Q + (size_t)qidx * A.qpitch + 8 * hi;
#pragma unroll
      for (int s = 0; s < NSTEP; ++s) qr[s] = *(const bf16x8*)(qp + 16 * s); }
    const float pqf = (MODE == 0) ? A.posf[qidx] : 0.f;
    const int krow_ = tid >> 3, kch_ = (tid & 7) ^ ((krow_ >> 1) & 7);
    const unsigned kofs = (unsigned)(krow_ * A.kpitch + kch_ * 8) * 2u;
    const unsigned k2ofs = (MODE == 1) ? (unsigned)(krow_ * A.k2pitch + kch_ * 8) * 2u : 0u;
    const unsigned vofs = (unsigned)((((tid >> 5) / NDB) * 8 + ((tid >> 2) & 7)) * A.vpitch + ((tid >> 5) % NDB) * 32 + (tid & 3) * 8) * 2u;
    auto issueK = [&](int t, int) {
        const unsigned dst = (unsigned)__builtin_amdgcn_readfirstlane((int)(unsigned)(uintptr_t)(lds + KOFF + (t & 1) * KBYTES + wid * 1024));
        const char* kb0 = (const char*)(A.K + (size_t)t * 64 * A.kpitch) + kofs;
        glds16(kb0, dst); glds16(kb0 + 128, dst + 8192);
        if (MODE == 1) glds16((const char*)(A.K2 + (size_t)t * 64 * A.k2pitch) + k2ofs, dst + 16384);
        if (MODE == 0) { if (lane < 16) glds16(A.posf + t * 64 + lane * 4, (unsigned)__builtin_amdgcn_readfirstlane((int)(unsigned)(uintptr_t)(lds + POSOFF + (t & 1) * 256))); }
    };
    auto issueV = [&](int t, int) {
        const unsigned dst = (unsigned)__builtin_amdgcn_readfirstlane((int)(unsigned)(uintptr_t)(lds + VOFF + (t % 3) * VBYTES + wid * 1024));
        const char* vb0 = (const char*)(A.V + (size_t)t * 64 * A.vpitch) + vofs;
#pragma unroll
        for (int rd = 0; rd < VBATCH; ++rd) glds16(vb0 + (size_t)rd * (128 / NDB) * A.vpitch * 2, dst + rd * 8192);
    };
    { int tq = tid; asm volatile("" : "+v"(tq)); issueK(0, tq); issueV(0, tq); }
#pragma unroll
    for (int db = 0; db < NDB; ++db)
#pragma unroll
        for (int r = 0; r < 16; ++r) o[db][r] = 0.f;
    float mrun = -1.0e30f, lrun = 0.f;
    const float k2 = (MODE == 0) ? A.slope2 / A.c1 : 0.f;
    bf16x8 pa[4];
#pragma unroll
    for (int i = 0; i < 4; ++i) pa[i] = (bf16x8){0, 0, 0, 0, 0, 0, 0, 0};

    auto qks = [&](int t, int tq) {
        if (64 * t > qrow0 + 31) return;
        const int lq = tq & 63, r32q = lq & 31, hiq = lq >> 5;
        const int koff = r32q * 128, kx = (r32q >> 1) & 7;
        const ALAS unsigned char* kbuf = lds + KOFF + (t & 1) * KBYTES;
        f32x16 s0, s1;
#pragma unroll
        for (int r = 0; r < 16; ++r) { s0[r] = 0.f; s1[r] = 0.f; }
        __builtin_amdgcn_s_setprio(2);
#pragma unroll
        for (int s = 0; s < NSTEP; ++s) {
            const int kb = s >> 2, ch = 2 * (s & 3) + hiq;
            const ALAS unsigned char* p = kbuf + kb * 8192 + koff + ((ch ^ kx) * 16);
            const bf16x8 k0 = *(const ALAS bf16x8*)p, k1 = *(const ALAS bf16x8*)(p + 4096);
            s0 = __builtin_amdgcn_mfma_f32_32x32x16_bf16(k0, qr[s], s0, 0, 0, 0);
            s1 = __builtin_amdgcn_mfma_f32_32x32x16_bf16(k1, qr[s], s1, 0, 0, 0);

        }
        __builtin_amdgcn_s_setprio(0);
        if (MODE == 0) {
            const ALAS float* pk = (const ALAS float*)(lds + POSOFF + (t & 1) * 256);
#pragma unroll
            for (int g = 0; g < 4; ++g) {
                const f32x4 p0 = *(const ALAS f32x4*)(pk + 8 * g + 4 * hiq), p1 = *(const ALAS f32x4*)(pk + 32 + 8 * g + 4 * hiq);
#pragma unroll
                for (int j = 0; j < 4; ++j) {
                    s0[4 * g + j] = __builtin_fmaf(-k2, __builtin_fabsf(pqf - p0[j]), s0[4 * g + j]);
                    s1[4 * g + j] = __builtin_fmaf(-k2, __builtin_fabsf(pqf - p1[j]), s1[4 * g + j]);
                }
            }
        }
        if (64 * t + 63 > qrow0) {
#pragma unroll
            for (int r = 0; r < 16; ++r) { const int kv = 64 * t + crow(r, hi); if (kv > qidx) s0[r] = -INFINITY; if (kv + 32 > qidx) s1[r] = -INFINITY; }
        }
        if (MODE == 1) asm volatile("s_nop 15\n\ts_nop 7" : "+v"(s0), "+v"(s1));
        float mx = rowmax32(s0, s1);
        { auto rr = __builtin_amdgcn_permlane32_swap(__float_as_uint(mx), __float_as_uint(mx), false, false); mx = __builtin_fmaxf(__uint_as_float(rr[0]), __uint_as_float(rr[1])); }
        if (__any(mx > mrun)) {
            const float mnew = __builtin_fmaxf(mrun, mx);
            const float alpha = __builtin_amdgcn_exp2f((mrun - mnew) * A.c1);
            mrun = mnew; lrun *= alpha;
#pragma unroll
            for (int db = 0; db < NDB; ++db)
#pragma unroll
                for (int r = 0; r < 16; ++r) o[db][r] *= alpha;
        }
        const float nm = -mrun * A.c1;
        lrun += exp_sum32(s0, s1, A.c1, nm);
        { u32x4 w;
          w.x = cvtpk(s0[0], s0[1]); w.y = cvtpk(s0[2], s0[3]); w.z = cvtpk(s0[4], s0[5]); w.w = cvtpk(s0[6], s0[7]); pa[0] = __builtin_bit_cast(bf16x8, w);
          w.x = cvtpk(s0[8], s0[9]); w.y = cvtpk(s0[10], s0[11]); w.z = cvtpk(s0[12], s0[13]); w.w = cvtpk(s0[14], s0[15]); pa[1] = __builtin_bit_cast(bf16x8, w);
          w.x = cvtpk(s1[0], s1[1]); w.y = cvtpk(s1[2], s1[3]); w.z = cvtpk(s1[4], s1[5]); w.w = cvtpk(s1[6], s1[7]); pa[2] = __builtin_bit_cast(bf16x8, w);
          w.x = cvtpk(s1[8], s1[9]); w.y = cvtpk(s1[10], s1[11]); w.z = cvtpk(s1[12], s1[13]); w.w = cvtpk(s1[14], s1[15]); pa[3] = __builtin_bit_cast(bf16x8, w); }
    };
    auto pv = [&](int t, int tq) {
        if (64 * t > qrow0 + 31) return;
        const int lq = tq & 63, hiq = lq >> 5;
        const int voff = (4 * hiq + ((lq & 15) >> 2)) * 64 + ((lq >> 4) & 1) * 32 + (lq & 3) * 8;
        const ALAS unsigned char* vbuf = lds + VOFF + (t % 3) * VBYTES;
#pragma unroll
        for (int db = 0; db < NDB; ++db) {
#pragma unroll
            for (int ks = 0; ks < 4; ++ks) {
                const ALAS unsigned char* vp = vbuf + ((2 * ks) * NDB + db) * 512 + voff;
                const s16x4 lo = vtr(vp), hh = vtr(vp + NDB * 512);
                const bf16x8 vf = (bf16x8){lo[0], lo[1], lo[2], lo[3], hh[0], hh[1], hh[2], hh[3]};
                o[db] = __builtin_amdgcn_mfma_f32_32x32x16_bf16(vf, pa[ks], o[db], 0, 0, 0);
            }

        }
    };
    if (grp == 0) {
        for (int t = 0; t <= NT; ++t) {
            ATT_WAITV(0);
            __builtin_amdgcn_s_barrier();
            asm volatile("" ::: "memory");
            int tq = tid; asm volatile("" : "+v"(tq));
            if (t + 1 < NT) { issueK(t + 1, tq); issueV(t + 1, tq); }
            if (t < NT) { qks(t, tq); pv(t, tq); }
        }
    } else {
        for (int t = 0; t <= NT; ++t) {
            ATT_WAITV(0);
            __builtin_amdgcn_s_barrier();
            asm volatile("" ::: "memory");
            int tq = tid; asm volatile("" : "+v"(tq));
            if (t + 1 < NT) { issueK(t + 1, tq); issueV(t + 1, tq); }
            if (t >= 1) pv(t - 1, tq);
            if (t < NT) qks(t, tq);
        }
    }
    asm volatile("s_waitcnt lgkmcnt(0)" ::: "memory");
    __syncthreads();
    const float lt = lrun + __shfl_xor(lrun, 32);
    return 1.0f / lt;
}

__device__ __forceinline__ float attn_mla_lag(ALAS unsigned char* lds, const Args& A, int q0, f32x16 (&o)[4]) {
    constexpr int KBYTES = 24576, VBYTES = 16384, KOFF = 0, VOFF = 2 * KBYTES, NSTEP = 12, NDB = 4;
    const int tid = threadIdx.x, lane = tid & 63, r32 = lane & 31, hi = lane >> 5; const int wid = __builtin_amdgcn_readfirstlane(tid >> 6);
    const int qrow0 = q0 + 32 * wid, qidx = qrow0 + r32;
    const int NT = (q0 + 256) / 64, ta = qrow0 >> 6;
    bf16x8 qr[NSTEP];
    { const bf16_t* qp = A.Q + (size_t)qidx * A.qpitch + 8 * hi;
#pragma unroll
      for (int s = 0; s < NSTEP; ++s) qr[s] = *(const bf16x8*)(qp + 16 * s); }
    const int krow_ = tid >> 3, kch_ = (tid & 7) ^ ((krow_ >> 1) & 7);
    const unsigned kofs = (unsigned)(krow_ * A.kpitch + kch_ * 8) * 2u;
    const unsigned k2ofs = (unsigned)(krow_ * A.k2pitch + kch_ * 8) * 2u;
    const unsigned vofs = (unsigned)((((tid >> 5) / NDB) * 8 + ((tid >> 2) & 7)) * A.vpitch + ((tid >> 5) % NDB) * 32 + (tid & 3) * 8) * 2u;
    auto issueK = [&](int t) {
        const unsigned dst = (unsigned)__builtin_amdgcn_readfirstlane((int)(unsigned)(uintptr_t)(lds + KOFF + (t & 1) * KBYTES + wid * 1024));
        const char* kb0 = (const char*)(A.K + (size_t)t * 64 * A.kpitch) + kofs;
        glds16(kb0, dst); glds16(kb0 + 128, dst + 8192);
        glds16((const char*)(A.K2 + (size_t)t * 64 * A.k2pitch) + k2ofs, dst + 16384);
    };
    auto issueV = [&](int t) {
        const unsigned dst = (unsigned)__builtin_amdgcn_readfirstlane((int)(unsigned)(uintptr_t)(lds + VOFF + (t & 1) * VBYTES + wid * 1024));
        const char* vb0 = (const char*)(A.V + (size_t)t * 64 * A.vpitch) + vofs;
        glds16(vb0, dst); glds16(vb0 + (size_t)32 * A.vpitch * 2, dst + 8192);
    };
#pragma unroll
    for (int db = 0; db < NDB; ++db)
#pragma unroll
        for (int r = 0; r < 16; ++r) o[db][r] = 0.f;
    float mrun = -1.0e30f, lrun = 0.f;
    bf16x8 pa[4];
#pragma unroll
    for (int i = 0; i < 4; ++i) pa[i] = (bf16x8){0, 0, 0, 0, 0, 0, 0, 0};
    const int koff = r32 * 128, kx = (r32 >> 1) & 7;
    const int voff = (4 * hi + ((lane & 15) >> 2)) * 64 + ((lane >> 4) & 1) * 32 + (lane & 3) * 8;
    f32x16 s0, s1;
    auto qk = [&](int t) {
        const ALAS unsigned char* kbuf = lds + KOFF + (t & 1) * KBYTES;
        const f32x16 z = {0.f, 0.f, 0.f, 0.f, 0.f, 0.f, 0.f, 0.f, 0.f, 0.f, 0.f, 0.f, 0.f, 0.f, 0.f, 0.f};
#pragma unroll
        for (int s = 0; s < NSTEP; ++s) {
            const int kb = s >> 2, ch = 2 * (s & 3) + hi;
            const ALAS unsigned char* p = kbuf + kb * 8192 + koff + ((ch ^ kx) * 16);
            const bf16x8 k0 = *(const ALAS bf16x8*)p, k1 = *(const ALAS bf16x8*)(p + 4096);
            s0 = __builtin_amdgcn_mfma_f32_32x32x16_bf16(k0, qr[s], s == 0 ? z : s0, 0, 0, 0);
            s1 = __builtin_amdgcn_mfma_f32_32x32x16_bf16(k1, qr[s], s == 0 ? z : s1, 0, 0, 0);
        }
        asm volatile("s_nop 15\n\ts_nop 7" : "+v"(s0), "+v"(s1));
    };
    auto pvl = [&](int t) {
        const ALAS unsigned char* vbuf = lds + VOFF + (t & 1) * VBYTES;
#pragma unroll
        for (int db = 0; db < NDB; ++db) {
#pragma unroll
            for (int ks = 0; ks < 4; ++ks) {
                const ALAS unsigned char* vp = vbuf + ((2 * ks) * NDB + db) * 512 + voff;
                const s16x4 lo = vtr(vp), hh = vtr(vp + NDB * 512);
                const bf16x8 vf = (bf16x8){lo[0], lo[1], lo[2], lo[3], hh[0], hh[1], hh[2], hh[3]};
                o[db] = __builtin_amdgcn_mfma_f32_32x32x16_bf16(vf, pa[ks], o[db], 0, 0, 0);
            }
        }
    };
    auto packp = [&]() {
        u32x4 w;
        w.x = cvtpk(s0[0], s0[1]); w.y = cvtpk(s0[2], s0[3]); w.z = cvtpk(s0[4], s0[5]); w.w = cvtpk(s0[6], s0[7]); pa[0] = __builtin_bit_cast(bf16x8, w);
        w.x = cvtpk(s0[8], s0[9]); w.y = cvtpk(s0[10], s0[11]); w.z = cvtpk(s0[12], s0[13]); w.w = cvtpk(s0[14], s0[15]); pa[1] = __builtin_bit_cast(bf16x8, w);
        w.x = cvtpk(s1[0], s1[1]); w.y = cvtpk(s1[2], s1[3]); w.z = cvtpk(s1[4], s1[5]); w.w = cvtpk(s1[6], s1[7]); pa[2] = __builtin_bit_cast(bf16x8, w);
        w.x = cvtpk(s1[8], s1[9]); w.y = cvtpk(s1[10], s1[11]); w.z = cvtpk(s1[12], s1[13]); w.w = cvtpk(s1[14], s1[15]); pa[3] = __builtin_bit_cast(bf16x8, w);
    };
    auto top = [&](int t) {
        ATT_WAITV(0);
        __builtin_amdgcn_s_barrier();
        asm volatile("" ::: "memory");
        if (t + 1 < NT) issueK(t + 1);
        if (t < NT) issueV(t);
    };
    auto gen = [&](int t) {
        top(t);
        const bool act = t <= ta && t < NT;
        if (act) qk(t);
        if (t >= 1 && t - 1 <= ta) pvl(t - 1);
        if (act) {
            if (64 * t + 63 > qrow0) {
#pragma unroll
                for (int r = 0; r < 16; ++r) { const int kv = 64 * t + crow(r, hi); if (kv > qidx) s0[r] = -INFINITY; if (kv + 32 > qidx) s1[r] = -INFINITY; }
            }
            float mx = rowmax32(s0, s1);
            { auto rr = __builtin_amdgcn_permlane32_swap(__float_as_uint(mx), __float_as_uint(mx), false, false); mx = __builtin_fmaxf(__uint_as_float(rr[0]), __uint_as_float(rr[1])); }
            if (__any(mx > mrun)) {
                const float mnew = __builtin_fmaxf(mrun, mx);
                const float alpha = __builtin_amdgcn_exp2f((mrun - mnew) * A.c1);
                mrun = mnew; lrun *= alpha;
#pragma unroll
                for (int db = 0; db < NDB; ++db)
#pragma unroll
                    for (int r = 0; r < 16; ++r) o[db][r] *= alpha;
            }
            lrun += exp_sum32(s0, s1, A.c1, -mrun * A.c1);
            packp();
        }
    };
    issueK(0);
    gen(0);
#pragma unroll 1
    for (int t = 1; t < ta; ++t) {
        top(t);
        qk(t);
        float alpha;
        {
            const ALAS unsigned char* vbuf = lds + VOFF + ((t - 1) & 1) * VBYTES;
            s16x4 vl0, vh0, vl1, vh1;
#define MLA_LD(i, LO, HH) do { if ((i) < 16) { const int ks_ = (i) >> 2, db_ = (i) & 3; const ALAS unsigned char* vp_ = vbuf + ((2 * ks_) * NDB + db_) * 512 + voff; LO = vtr(vp_); HH = vtr(vp_ + NDB * 512); } } while (0)
#define MLA_MM(i, LO, HH) do { const int ks_ = (i) >> 2, db_ = (i) & 3; const bf16x8 vf_ = (bf16x8){LO[0], LO[1], LO[2], LO[3], HH[0], HH[1], HH[2], HH[3]}; \
            o[db_] = __builtin_amdgcn_mfma_f32_32x32x16_bf16(vf_, pa[ks_], o[db_], 0, 0, 0); } while (0)
#define MLA_PVM(i) do { if ((i) & 1) { MLA_LD((i) + 1, vl0, vh0); MLA_MM(i, vl1, vh1); } else { MLA_LD((i) + 1, vl1, vh1); MLA_MM(i, vl0, vh0); } } while (0)
#define MLA_F() __builtin_amdgcn_sched_barrier(0)
#define MLA_EXPS(r) do { f32x2 a_ = (f32x2){s0[r], s0[r + 1]} * A.c1 + nm, b_ = (f32x2){s1[r], s1[r + 1]} * A.c1 + nm; \
            a_.x = __builtin_amdgcn_exp2f(a_.x); a_.y = __builtin_amdgcn_exp2f(a_.y); b_.x = __builtin_amdgcn_exp2f(b_.x); b_.y = __builtin_amdgcn_exp2f(b_.y); \
            s0[r] = a_.x; s0[r + 1] = a_.y; s1[r] = b_.x; s1[r + 1] = b_.y; acc += a_; acc += b_; } while (0)
            float ma, mb;
            MLA_LD(0, vl0, vh0);
            MLA_PVM(0); ma = max3f(s0[0], s0[1], s1[0]); mb = max3f(s0[2], s0[3], s1[1]); ma = max3f(ma, s1[2], s1[3]); ma = max3f(ma, s0[4], s0[5]); mb = max3f(mb, s0[6], s0[7]); ma = max3f(ma, s1[4], s1[5]); MLA_F();
            MLA_PVM(1); mb = max3f(mb, s1[6], s1[7]); ma = max3f(ma, s0[8], s0[9]); mb = max3f(mb, s0[10], s0[11]); ma = max3f(ma, s1[8], s1[9]); mb = max3f(mb, s1[10], s1[11]); ma = max3f(ma, s0[12], s0[13]); MLA_F();
            MLA_PVM(2); mb = max3f(mb, s0[14], s0[15]); ma = max3f(ma, s1[12], s1[13]); mb = max3f(mb, s1[14], s1[15]); float mx = max3f(ma, mb, mb); MLA_F();
            MLA_PVM(3);
            { auto rr = __builtin_amdgcn_permlane32_swap(__float_as_uint(mx), __float_as_uint(mx), false, false); mx = __builtin_fmaxf(__uint_as_float(rr[0]), __uint_as_float(rr[1])); }
            const float mnew = __builtin_fmaxf(mrun, mx);
            alpha = __builtin_amdgcn_exp2f((mrun - mnew) * A.c1);
            mrun = mnew;
            const float nm = -mrun * A.c1;
            f32x2 acc = {0.f, 0.f};
            MLA_F();
            MLA_PVM(4); MLA_EXPS(0); MLA_F();
            MLA_PVM(5); MLA_EXPS(2); MLA_F();
            MLA_PVM(6); MLA_EXPS(4); MLA_F();
            MLA_PVM(7); MLA_EXPS(6); MLA_F();
            MLA_PVM(8); MLA_EXPS(8); MLA_F();
            MLA_PVM(9); MLA_EXPS(10); MLA_F();
            MLA_PVM(10); MLA_EXPS(12); MLA_F();
            MLA_PVM(11); MLA_EXPS(14); MLA_F();
            MLA_PVM(12); lrun = __builtin_fmaf(lrun, alpha, acc.x + acc.y);
            { u32x4 w; w.x = cvtpk(s0[0], s0[1]); w.y = cvtpk(s0[2], s0[3]); w.z = cvtpk(s0[4], s0[5]); w.w = cvtpk(s0[6], s0[7]); pa[0] = __builtin_bit_cast(bf16x8, w); } MLA_F();
            MLA_PVM(13); { u32x4 w; w.x = cvtpk(s0[8], s0[9]); w.y = cvtpk(s0[10], s0[11]); w.z = cvtpk(s0[12], s0[13]); w.w = cvtpk(s0[14], s0[15]); pa[1] = __builtin_bit_cast(bf16x8, w); } MLA_F();
            MLA_PVM(14); { u32x4 w; w.x = cvtpk(s1[0], s1[1]); w.y = cvtpk(s1[2], s1[3]); w.z = cvtpk(s1[4], s1[5]); w.w = cvtpk(s1[6], s1[7]); pa[2] = __builtin_bit_cast(bf16x8, w); } MLA_F();
            MLA_PVM(15); MLA_F();
            { u32x4 w; w.x = cvtpk(s1[8], s1[9]); w.y = cvtpk(s1[10], s1[11]); w.z = cvtpk(s1[12], s1[13]); w.w = cvtpk(s1[14], s1[15]); pa[3] = __builtin_bit_cast(bf16x8, w); }
#undef MLA_PVM
#undef MLA_LD
#undef MLA_MM
#undef MLA_F
#undef MLA_EXPS
        }
        __builtin_amdgcn_sched_barrier(0);
        if (__any(alpha != 1.0f)) {
#pragma unroll
            for (int db = 0; db < NDB; ++db)
#pragma unroll
                for (int r = 0; r < 16; ++r) o[db][r] *= alpha;
        }
    }
#pragma unroll 1
    for (int t = (ta > 1 ? ta : 1); t <= NT; ++t) gen(t);
    asm volatile("s_waitcnt lgkmcnt(0)" ::: "memory");
    __syncthreads();
    const float lt = lrun + __shfl_xor(lrun, 32);
    return 1.0f / lt;
}
constexpr int PR_K = 0, PR_V = 32768, PR_POS = 131072, PR_P = 131072 + 512, PR_AL = PR_P + 16384, PR_FLAG = PR_AL + 1024, PR_X = PR_FLAG + 256, PR_BND = PR_X + 4096, PR_STOP = PR_BND + 3072, PR_END = PR_STOP + 64;
__device__ __forceinline__ float attn_diff_pair(ALAS unsigned char* lds, const Args& A, int q0, f32x16 (&o)[4]) {
    const int tid = threadIdx.x, lane = tid & 63, r32 = lane & 31, hi = lane >> 5; const int wid = __builtin_amdgcn_readfirstlane(tid >> 6);
    const int pw = wid & 3;
    const bool prod = wid < 4;
    const int qrow0 = q0 + 32 * pw, qidx = qrow0 + r32;
    const int NT = (q0 + 128) / 64;
    bf16x8 qr[8];
    float pqs = 0.f, qn = 0.f;
    if (prod) {
        const bf16_t* qp = A.Q + (size_t)qidx * A.qpitch + 8 * hi;
#pragma unroll
        for (int s = 0; s < 8; ++s) qr[s] = *(const bf16x8*)(qp + 16 * s);
        pqs = A.posf[qidx];
        float ssq = 0.f;
#pragma unroll
        for (int s = 0; s < 8; ++s)
#pragma unroll
            for (int j = 0; j < 8; ++j) { const float v = __uint_as_float(((unsigned)(unsigned short)qr[s][j]) << 16); ssq += v * v; }
        ssq += __shfl_xor(ssq, 32);
        qn = sqrtf(ssq) * 1.002f;
    } else {
#pragma unroll
        for (int s = 0; s < 8; ++s) qr[s] = (bf16x8){0, 0, 0, 0, 0, 0, 0, 0};
    }
    const int l0 = tid - 256;
    const unsigned kofs = (unsigned)((l0 >> 3) * A.kpitch + (((l0 & 7) ^ ((l0 >> 4) & 7)) * 8)) * 2u;
    const unsigned vofs = (unsigned)(((l0 >> 2) & 7) * A.vpitch + (l0 >> 5) * 32 + (l0 & 3) * 8) * 2u;
    auto issueKV = [&](int t, int st) {
        const char* kb = (const char*)(A.K + (size_t)t * 64 * A.kpitch) + kofs;
        const char* vbp = (const char*)(A.V + (size_t)t * 64 * A.vpitch) + vofs;
        const unsigned kdst = (unsigned)__builtin_amdgcn_readfirstlane((int)(unsigned)(uintptr_t)(lds + PR_K + (st & 1) * 16384 + (wid - 4) * 1024));
        const unsigned vdst = (unsigned)__builtin_amdgcn_readfirstlane((int)(unsigned)(uintptr_t)(lds + PR_V + (st % 3) * 32768 + (wid - 4) * 1024));
#pragma unroll
        for (int v = 0; v < 2; ++v) { const char* ksrc = kb + (size_t)v * 32 * A.kpitch * 2;
            glds16(ksrc, kdst + v * 4096); glds16(ksrc + 128, kdst + v * 4096 + 8192); }
        if (lane < 16) glds16(A.posf + t * 64 + lane * 4, (unsigned)__builtin_amdgcn_readfirstlane((int)(unsigned)(uintptr_t)(lds + PR_POS + (st & 1) * 256)));
#pragma unroll
        for (int v = 0; v < 2; ++v)
#pragma unroll
            for (int rd = 0; rd < 4; ++rd) glds16(vbp + (size_t)(v * 8 + rd * 16) * A.vpitch * 2, vdst + v * 4096 + rd * 8192);
    };
    if (!prod) issueKV(NT - 1, 0);
    ALAS float* bnd = (ALAS float*)(lds + PR_BND);
    volatile ALAS unsigned* stopw = (volatile ALAS unsigned*)(lds + PR_STOP);
    if (wid == 4) {
        f32x4 km = *((const f32x4*)A.kmaxt + lane), px = *((const f32x4*)A.pmaxt + lane), pn = *((const f32x4*)A.pmint + lane);
        km.y = __builtin_fmaxf(km.x, km.y); km.z = __builtin_fmaxf(km.y, km.z); km.w = __builtin_fmaxf(km.z, km.w);
        px.y = __builtin_fmaxf(px.x, px.y); px.z = __builtin_fmaxf(px.y, px.z); px.w = __builtin_fmaxf(px.z, px.w);
        pn.y = __builtin_fminf(pn.x, pn.y); pn.z = __builtin_fminf(pn.y, pn.z); pn.w = __builtin_fminf(pn.z, pn.w);
        float tk = km.w, tx = px.w, tn = pn.w;
#pragma unroll
        for (int d = 1; d < 64; d <<= 1) { const float a = __shfl_up(tk, d), b = __shfl_up(tx, d), c = __shfl_up(tn, d); if (lane >= d) { tk = __builtin_fmaxf(tk, a); tx = __builtin_fmaxf(tx, b); tn = __builtin_fminf(tn, c); } }
        float ek = __shfl_up(tk, 1), ex = __shfl_up(tx, 1), en = __shfl_up(tn, 1);
        if (lane == 0) { ek = 0.f; ex = -3.0e38f; en = 3.0e38f; }
#pragma unroll
        for (int j = 0; j < 4; ++j) { km[j] = __builtin_fmaxf(km[j], ek); px[j] = __builtin_fmaxf(px[j], ex); pn[j] = __builtin_fminf(pn[j], en); }
        *((ALAS f32x4*)bnd + lane) = km; *((ALAS f32x4*)(bnd + 256) + lane) = px; *((ALAS f32x4*)(bnd + 512) + lane) = pn;
        if (lane < 8) stopw[lane] = 0u;
    }
    int nsteps = NT;
    volatile ALAS unsigned* flagp = (volatile ALAS unsigned*)(lds + PR_FLAG) + pw;
    if (prod && lane == 0) *flagp = 0u;
#pragma unroll
    for (int db = 0; db < 4; ++db)
#pragma unroll
        for (int r = 0; r < 16; ++r) o[db][r] = 0.f;
    float mrun = -1.0e30f, lrun = 0.f;
    bf16x8 pa[4];
#pragma unroll
    for (int i = 0; i < 4; ++i) pa[i] = (bf16x8){0, 0, 0, 0, 0, 0, 0, 0};
    ALAS unsigned char* pslot = lds + PR_P + pw * 4096 + lane * 16;
    ALAS float* aslot = (ALAS float*)(lds + PR_AL + pw * 256) + lane;
#define ATT_FENCE() __builtin_amdgcn_sched_barrier(0)
    bf16x8 fa[4], fb[4];
    f32x16 s0, s1;
    auto ldK = [&](bf16x8 (&f)[4], int b, const ALAS unsigned char* kbuf, int koff, int kx, int hiq) {
#pragma unroll
        for (int i = 0; i < 2; ++i) { const int s = 2 * b + i, kb = s >> 2, ch = 2 * (s & 3) + hiq;
            const ALAS unsigned char* p = kbuf + kb * 8192 + koff + ((ch ^ kx) * 16);
            f[2 * i] = *(const ALAS bf16x8*)p; f[2 * i + 1] = *(const ALAS bf16x8*)(p + 4096); }
    };
    auto mmK = [&](const bf16x8 (&f)[4], int b) {
#pragma unroll
        for (int i = 0; i < 2; ++i) { const int s = 2 * b + i;
            if (s == 0) { const f32x16 z = {0.f, 0.f, 0.f, 0.f, 0.f, 0.f, 0.f, 0.f, 0.f, 0.f, 0.f, 0.f, 0.f, 0.f, 0.f, 0.f};
                s0 = __builtin_amdgcn_mfma_f32_32x32x16_bf16(f[0], qr[0], z, 0, 0, 0); s1 = __builtin_amdgcn_mfma_f32_32x32x16_bf16(f[1], qr[0], z, 0, 0, 0); }
            else {
            s0 = __builtin_amdgcn_mfma_f32_32x32x16_bf16(f[2 * i], qr[s], s0, 0, 0, 0);
            s1 = __builtin_amdgcn_mfma_f32_32x32x16_bf16(f[2 * i + 1], qr[s], s1, 0, 0, 0); } }
    };
    auto ldV = [&](bf16x8 (&f)[4], int ks, const ALAS unsigned char* vb) {
#pragma unroll
        for (int db = 0; db < 4; ++db) { const ALAS unsigned char* vp = vb + ((2 * ks) * 8 + db) * 512;
            const s16x4 lo = vtr(vp), hh = vtr(vp + 8 * 512);
            f[db] = (bf16x8){lo[0], lo[1], lo[2], lo[3], hh[0], hh[1], hh[2], hh[3]}; }
    };
    auto mmV = [&](const bf16x8 (&f)[4], int ks) {
#pragma unroll
        for (int db = 0; db < 4; ++db) o[db] = __builtin_amdgcn_mfma_f32_32x32x16_bf16(f[db], pa[ks], o[db], 0, 0, 0);
    };
    if (prod) {
        __builtin_amdgcn_s_setprio(3);
        for (int it = 0; it <= nsteps; ++it) {
            __builtin_amdgcn_s_barrier();
            asm volatile("" ::: "memory");
            if (it >= 1) { const unsigned sv = stopw[((it - 1) & 1) * 4] & stopw[((it - 1) & 1) * 4 + 1] & stopw[((it - 1) & 1) * 4 + 2] & stopw[((it - 1) & 1) * 4 + 3];
                if (__builtin_amdgcn_readfirstlane((int)sv) != 0 && it < nsteps) nsteps = it; }
            const int t = NT - 1 - it;
            int tq = tid; asm volatile("" : "+v"(tq));
            const bool act = (it < nsteps) && (64 * t <= qrow0 + 31);
            const bool actp = (it >= 1) && (64 * (t + 1) <= qrow0 + 31);
            const int lq = tq & 63, r32q = lq & 31, hiq = lq >> 5;
            const int koff = r32q * 128, kx = (r32q >> 1) & 7;
            const int voff = (4 * hiq + ((lq & 15) >> 2)) * 64 + ((lq >> 4) & 1) * 32 + (lq & 3) * 8;
            const ALAS unsigned char* kbuf = lds + PR_K + (it & 1) * 16384;
            const ALAS unsigned char* vb = lds + PR_V + ((it + 2) % 3) * 32768 + voff;
            if (act) {
                ldK(fa, 0, kbuf, koff, kx, hiq); ldK(fb, 1, kbuf, koff, kx, hiq); ATT_FENCE();
                mmK(fa, 0); ATT_FENCE(); ldK(fa, 2, kbuf, koff, kx, hiq); ATT_FENCE();
                mmK(fb, 1); ATT_FENCE(); ldK(fb, 3, kbuf, koff, kx, hiq); ATT_FENCE();
                mmK(fa, 2); ATT_FENCE();
            }
            if (actp) { ldV(fa, 0, vb); ATT_FENCE(); }
            if (act) { mmK(fb, 3); ATT_FENCE(); }
            if (actp) {
                ldV(fb, 1, vb); ATT_FENCE();
                mmV(fa, 0); ATT_FENCE(); ldV(fa, 2, vb); ATT_FENCE();
                mmV(fb, 1); ATT_FENCE(); ldV(fb, 3, vb); ATT_FENCE();
                mmV(fa, 2); ATT_FENCE(); mmV(fb, 3); ATT_FENCE();
            }
            if (act) {
                const ALAS float* pk = (const ALAS float*)(lds + PR_POS + (it & 1) * 256);
                const f32x4 pq4 = {pqs, pqs, pqs, pqs};
#pragma unroll
                for (int g = 0; g < 4; ++g) {
                    const f32x4 p0 = *(const ALAS f32x4*)(pk + 8 * g + 4 * hiq), p1 = *(const ALAS f32x4*)(pk + 32 + 8 * g + 4 * hiq);
                    const f32x4 d0 = pq4 - p0, d1 = pq4 - p1;
#pragma unroll
                    for (int j = 0; j < 4; ++j) {
                        s0[4 * g + j] = s0[4 * g + j] - __builtin_fabsf(d0[j]);
                        s1[4 * g + j] = s1[4 * g + j] - __builtin_fabsf(d1[j]);
                    }
                }
                if (64 * t + 63 > qrow0) {
#pragma unroll
                    for (int r = 0; r < 16; ++r) { const int kv = 64 * t + crow(r, hi); if (kv > qidx) s0[r] = -INFINITY; if (kv + 32 > qidx) s1[r] = -INFINITY; }
                }
                float mx = rowmax32(s0, s1);
                { auto rr = __builtin_amdgcn_permlane32_swap(__float_as_uint(mx), __float_as_uint(mx), false, false); mx = __builtin_fmaxf(__uint_as_float(rr[0]), __uint_as_float(rr[1])); }
                float alpha = 1.0f;
                if (__any(mx > mrun)) {
                    const float mnew = __builtin_fmaxf(mrun, mx);
                    alpha = __builtin_amdgcn_exp2f((mrun - mnew) * A.c1);
                    mrun = mnew; lrun *= alpha;
#pragma unroll
                    for (int db = 0; db < 4; ++db)
#pragma unroll
                        for (int r = 0; r < 16; ++r) o[db][r] *= alpha;
                }
                const float nm = -mrun * A.c1;
                lrun += exp_sum32(s0, s1, A.c1, nm);
                { u32x4 w;
                  w.x = cvtpk(s0[0], s0[1]); w.y = cvtpk(s0[2], s0[3]); w.z = cvtpk(s0[4], s0[5]); w.w = cvtpk(s0[6], s0[7]); pa[0] = __builtin_bit_cast(bf16x8, w);
                  w.x = cvtpk(s0[8], s0[9]); w.y = cvtpk(s0[10], s0[11]); w.z = cvtpk(s0[12], s0[13]); w.w = cvtpk(s0[14], s0[15]); pa[1] = __builtin_bit_cast(bf16x8, w);
                  w.x = cvtpk(s1[0], s1[1]); w.y = cvtpk(s1[2], s1[3]); w.z = cvtpk(s1[4], s1[5]); w.w = cvtpk(s1[6], s1[7]); pa[2] = __builtin_bit_cast(bf16x8, w);
                  w.x = cvtpk(s1[8], s1[9]); w.y = cvtpk(s1[10], s1[11]); w.z = cvtpk(s1[12], s1[13]); w.w = cvtpk(s1[14], s1[15]); pa[3] = __builtin_bit_cast(bf16x8, w); }
                if (actp) { while (*flagp != (unsigned)it) __builtin_amdgcn_s_sleep(1); }
                asm volatile("" ::: "memory");
#pragma unroll
                for (int ks = 0; ks < 4; ++ks) *(ALAS bf16x8*)(pslot + ks * 1024) = pa[ks];
                *aslot = alpha;
            }
            if (it < nsteps) {
                unsigned vote = 0u;
                if (act && t >= 1) {
                    const float ks = bnd[t - 1], px = bnd[256 + t - 1], pn = bnd[512 + t - 1];
                    const float ds = __builtin_fmaxf(0.f, __builtin_fmaxf(pqs - px, pn - pqs));
                    vote = __all(qn * ks - ds - mrun < -1200.0f) ? 1u : 0u;
                }
                if (lane == 0) stopw[(it & 1) * 4 + pw] = vote;
            }
            asm volatile("s_waitcnt lgkmcnt(0)" ::: "memory");
        }
        __builtin_amdgcn_s_setprio(0);
    } else {
        for (int it = 0; it <= nsteps; ++it) {
            if (it < NT) ATT_WAITV(8); else ATT_WAITV(0);
            __builtin_amdgcn_s_barrier();
            asm volatile("" ::: "memory");
            if (it >= 1) { const unsigned sv = stopw[((it - 1) & 1) * 4] & stopw[((it - 1) & 1) * 4 + 1] & stopw[((it - 1) & 1) * 4 + 2] & stopw[((it - 1) & 1) * 4 + 3];
                if (__builtin_amdgcn_readfirstlane((int)sv) != 0 && it < nsteps) nsteps = it; }
            const int t = NT - 1 - it;
            int tq = tid; asm volatile("" : "+v"(tq));
            if (it + 1 < nsteps) issueKV(t - 1, it + 1);
            const bool actp = (it >= 1) && (64 * (t + 1) <= qrow0 + 31);
            if (actp) {
                const int lq = tq & 63, hiq = lq >> 5;
                const int voff = (4 * hiq + ((lq & 15) >> 2)) * 64 + ((lq >> 4) & 1) * 32 + (lq & 3) * 8;
                const ALAS unsigned char* vb = lds + PR_V + ((it + 2) % 3) * 32768 + 4 * 512 + voff;
#pragma unroll
                for (int ks = 0; ks < 4; ++ks) pa[ks] = *(const ALAS bf16x8*)(pslot + ks * 1024);
                const float alpha = *aslot;
                asm volatile("s_waitcnt lgkmcnt(0)" ::: "memory");
                if (lane == 0) *flagp = (unsigned)it;
                asm volatile("" ::: "memory");
                ldV(fa, 0, vb); ldV(fb, 1, vb); ATT_FENCE();
                if (__any(alpha != 1.0f)) {
#pragma unroll
                    for (int db = 0; db < 4; ++db)
#pragma unroll
                        for (int r = 0; r < 16; ++r) o[db][r] *= alpha;
                }
                ATT_FENCE();
                mmV(fa, 0); ATT_FENCE(); ldV(fa, 2, vb); ATT_FENCE();
                mmV(fb, 1); ATT_FENCE(); ldV(fb, 3, vb); ATT_FENCE();
                mmV(fa, 2); ATT_FENCE(); mmV(fb, 3); ATT_FENCE();
            }
            asm volatile("s_waitcnt lgkmcnt(0)" ::: "memory");
        }
    }
    ALAS float* xs = (ALAS float*)(lds + PR_X) + pw * 64 + lane;
    float inv = 0.f;
    if (prod) { const float lt = lrun + __shfl_xor(lrun, 32); inv = 1.0f / lt; *xs = inv; }
    asm volatile("s_waitcnt vmcnt(0) lgkmcnt(0)" ::: "memory");
    __syncthreads();
    if (!prod) inv = *xs;
    return inv;
}
}

#define LAS __attribute__((address_space(3)))
typedef unsigned short bf16;
typedef float f32x4 __attribute__((ext_vector_type(4)));
typedef unsigned u32x4v __attribute__((ext_vector_type(4)));
typedef unsigned u32x2v __attribute__((ext_vector_type(2)));
constexpr int S = 16384, DM = 2048, FF = 5632;
constexpr int NTHREADS = 512, NWAVES = 8;
constexpr float EPS = 1e-6f;
constexpr int LDS_BYTES = 156672;
constexpr size_t MiB = 1u << 20;
constexpr size_t W_QKV = 0;
constexpr size_t W_DO = W_QKV + (size_t)6144 * 2048 * 2;
constexpr size_t W_DOWN = W_DO + (size_t)2048 * 2048 * 2;
constexpr size_t W_UQ = W_DOWN + (size_t)1280 * 2048 * 2;
constexpr size_t W_UKV = W_UQ + (size_t)3072 * 512 * 2;
constexpr size_t W_MO = W_UKV + (size_t)4096 * 512 * 2;
constexpr size_t W_FIN = W_MO + (size_t)2048 * 2048 * 2;
constexpr size_t W_FOUT = W_FIN + (size_t)2 * 11264 * 2048 * 2;
constexpr size_t W_END = W_FOUT + (size_t)2 * 2048 * 5632 * 2;
constexpr size_t WS_H = 192 * MiB;
constexpr size_t WS_C = 256 * MiB;
constexpr size_t WS_E = 480 * MiB;
constexpr size_t WS_G = 608 * MiB;
constexpr size_t WS_CQN = WS_G, WS_CKVN = WS_G + 16 * MiB, WS_KROPE = WS_G + 32 * MiB, WS_CS = WS_G + 34 * MiB, WS_POSF = WS_G + 38 * MiB;
constexpr size_t WS_KMAXT = WS_POSF + 640 * 1024, WS_PMAXT = WS_KMAXT + 16384, WS_PMINT = WS_PMAXT + 8192, WS_CTR = WS_PMINT + 8192;
constexpr size_t WS_BAR = WS_G + 38 * MiB + 768 * 1024;
constexpr size_t WS_END = WS_G + 39 * MiB;
static_assert(W_END <= WS_H, "weights fit");

struct Params {
    const float* x; const int* pos; const float* gains; const float* d_wqkv; const float* d_lam; const float* d_subln; const float* d_wo;
    const float* m_wdown; const float* m_qn; const float* m_kvn; const float* m_wuq; const float* m_wukv; const float* m_wo; const float* f_win; const float* f_wout;
    float* out; unsigned char* ws;
    float inv_freq[32];
    int ph_lo, ph_hi;
};

__device__ __forceinline__ unsigned f2bf(float f) { unsigned u = __builtin_bit_cast(unsigned, f); return (u + 0x7fffu + ((u >> 16) & 1u)) >> 16; }
__device__ __forceinline__ unsigned pk2(float lo, float hi) { return f2bf(lo) | (f2bf(hi) << 16); }
#define XB_TMO      128
#define XB_XCNT(j)  (256  + 64 * (j))
#define XB_XSUB(j)  (1280 + 64 * (j))
#define XB_XGEN(j)  (2304 + 64 * (j))
#define XB_TOP      3328
#define XB_TOPGEN   3392
#define XCD_BAR_WORDS 3456
#define XB_SPIN_CAP (1u << 18)

__device__ __forceinline__ unsigned xb_ld(unsigned* p)              { return __hip_atomic_load(p, __ATOMIC_RELAXED, __HIP_MEMORY_SCOPE_AGENT); }
__device__ __forceinline__ unsigned xb_add(unsigned* p, unsigned v) { return __hip_atomic_fetch_add(p, v, __ATOMIC_RELAXED, __HIP_MEMORY_SCOPE_AGENT); }
__device__ __forceinline__ unsigned xb_xcc_id() { return (unsigned)__builtin_amdgcn_s_getreg((3 << 11) | 20) & 0xFu; }
#define XB_SPIN(cond, bar) do { unsigned _sp = 0; while (cond) { __builtin_amdgcn_s_sleep(1); \
    if ((++_sp & 255u) == 0u) { if (xb_ld(&(bar)[XB_TMO])) break; if (_sp > XB_SPIN_CAP) { atomicAdd(&(bar)[XB_TMO], 1u); break; } } } } while (0)

struct XcdBarrier {
    unsigned* bar; unsigned x;
    volatile LAS unsigned* st;
};

__device__ __forceinline__ XcdBarrier xcd_barrier_post(unsigned* bar, volatile LAS unsigned* st) {
    XcdBarrier b; b.bar = bar; b.x = xb_xcc_id(); b.st = st;
    if (threadIdx.x == 0) (void)xb_add(&bar[XB_XCNT(b.x)], 1u);
    return b;
}
__device__ __forceinline__ void xcd_barrier_complete(unsigned* bar, unsigned x, unsigned& nloc, unsigned& nx) {
    const unsigned G = gridDim.x * gridDim.y * gridDim.z;
    unsigned sum, cnt, mine, sp = 0u;
    for (;;) {
        sum = 0u; cnt = 0u; mine = 0u;
#pragma unroll
        for (unsigned j = 0; j < 16; ++j) { const unsigned c = xb_ld(&bar[XB_XCNT(j)]); sum += c; cnt += (c > 0u) ? 1u : 0u; mine = (j == x) ? c : mine; }
        if (sum == G) break;
        __builtin_amdgcn_s_sleep(1);
        if ((++sp & 255u) == 0u) { if (xb_ld(&bar[XB_TMO])) break; if (sp > XB_SPIN_CAP) { atomicAdd(&bar[XB_TMO], 1u); break; } }
    }
    nloc = mine > 0u ? mine : 1u; nx = cnt > 0u ? cnt : 1u;
}

__device__ __forceinline__ void xcd_barrier(const XcdBarrier& b) {
    asm volatile("s_waitcnt vmcnt(0)" ::: "memory");
    __syncthreads();
    if (threadIdx.x == 0) {
        unsigned* bar = b.bar;
        __builtin_amdgcn_s_waitcnt(0);
        unsigned nloc = b.st[0], nx = b.st[1];
        if (nloc == 0u) { xcd_barrier_complete(bar, b.x, nloc, nx); b.st[0] = nloc; b.st[1] = nx; }
        const unsigned old = xb_add(&bar[XB_XSUB(b.x)], 1u);
        const unsigned gen = old / nloc;
        if (old + 1u == (gen + 1u) * nloc) {
            __builtin_amdgcn_fence(__ATOMIC_RELEASE, "agent");
            asm volatile("s_waitcnt vmcnt(0)" ::: "memory");
            const unsigned og = xb_add(&bar[XB_TOP], 1u);
            const unsigned tg = og / nx;
            if (og + 1u == (tg + 1u) * nx) xb_add(&bar[XB_TOPGEN], 1u);
            else XB_SPIN(xb_ld(&bar[XB_TOPGEN]) == tg, bar);
            __builtin_amdgcn_fence(__ATOMIC_ACQUIRE, "agent");
            xb_add(&bar[XB_XGEN(b.x)], 1u);
            asm volatile("s_waitcnt vmcnt(0)" ::: "memory");
        } else {
            XB_SPIN(xb_ld(&bar[XB_XGEN(b.x)]) == gen, bar);
            __builtin_amdgcn_fence(__ATOMIC_ACQUIRE, "agent");
            asm volatile("s_waitcnt vmcnt(0)" ::: "memory");
        }
    }
    __syncthreads();
}

__device__ __forceinline__ float wave_sum(float v) {
#pragma unroll
    for (int o = 1; o < 64; o <<= 1) v += __shfl_xor(v, o);
    return v;
}
__device__ __forceinline__ int dest_row(int mode, int n) {
    if (mode == 1) { const bool up = n >= FF; const int c = up ? n - FF : n; return (c >> 7) * 256 + (up ? 128 : 0) + (c & 127); }
    if (mode == 2) { const int head = n / 192, d = n % 192; if (d < 128) return head * 128 + d; const int i = d - 128; return 2048 + (head >> 2) * 256 + (i >> 5) * 128 + (head & 3) * 32 + (i & 31); }
    return n;
}
struct CvtItem { const float* W; bf16* WT; int K, N, mode, item; };
__device__ __forceinline__ void cvt_load(const CvtItem& c, int lane, f32x4 (&wv)[8]) {
    const int nblk = c.N / 32, kb = c.item / nblk, nb = c.item % nblk, k0 = 64 * kb, n0 = 32 * nb;
#pragma unroll
    for (int i = 0; i < 8; ++i) wv[i] = *(const f32x4*)(c.W + (size_t)(k0 + 8 * i + (lane >> 3)) * c.N + n0 + 4 * (lane & 7));
}
__device__ __forceinline__ void cvt_finish(const CvtItem& c, int lane, const f32x4 (&wv)[8], LAS float* scr) {
    const int nblk = c.N / 32, kb = c.item / nblk, nb = c.item % nblk, k0 = 64 * kb, n0 = 32 * nb;
#pragma unroll
    for (int i = 0; i < 8; ++i) { LAS float* d = scr + (8 * i + (lane >> 3)) * 33 + 4 * (lane & 7); d[0] = wv[i].x; d[1] = wv[i].y; d[2] = wv[i].z; d[3] = wv[i].w; }
    asm volatile("s_waitcnt lgkmcnt(0)" ::: "memory");
    const int cc = lane & 7;
#pragma unroll
    for (int j = 0; j < 4; ++j) { const int n = (lane >> 3) + 8 * j; const LAS float* s = scr + (8 * cc) * 33 + n;
        u32x4v o; o.x = pk2(s[0 * 33], s[1 * 33]); o.y = pk2(s[2 * 33], s[3 * 33]); o.z = pk2(s[4 * 33], s[5 * 33]); o.w = pk2(s[6 * 33], s[7 * 33]);
        *(u32x4v*)(c.WT + (size_t)dest_row(c.mode, n0 + n) * c.K + k0 + 8 * cc) = o; }
    asm volatile("s_waitcnt lgkmcnt(0)" ::: "memory");
}
__device__ __forceinline__ void load_row(const float* p, int lane, f32x4 (&v)[8]) {
#pragma unroll
    for (int j = 0; j < 8; ++j) v[j] = *((const f32x4*)p + 64 * j + lane);
}
__device__ __forceinline__ void load_row_bf16(const bf16* p, int lane, f32x4 (&v)[8]) {
#pragma unroll
    for (int j = 0; j < 8; ++j) { const u32x2v w = *((const u32x2v*)p + 64 * j + lane);
        v[j].x = __uint_as_float(w.x << 16); v[j].y = __uint_as_float(w.x & 0xffff0000u); v[j].z = __uint_as_float(w.y << 16); v[j].w = __uint_as_float(w.y & 0xffff0000u); }
}
__device__ __forceinline__ float sumsq_row(const f32x4 (&v)[8]) {
    float s = 0.f;
#pragma unroll
    for (int j = 0; j < 8; ++j) s += (v[j].x * v[j].x + v[j].y * v[j].y) + (v[j].z * v[j].z + v[j].w * v[j].w);
    return wave_sum(s);
}
__device__ __forceinline__ void norm_store_bf16(const f32x4 (&v)[8], const float* g, bf16* orow, int lane) {
    const float rs = 1.0f / sqrtf(sumsq_row(v) * (1.0f / DM) + EPS);
#pragma unroll
    for (int j = 0; j < 8; ++j) { const f32x4 gg = *((const f32x4*)g + 64 * j + lane); const f32x4 t = v[j] * rs * gg;
        u32x2v w; w.x = pk2(t.x, t.y); w.y = pk2(t.z, t.w); *((u32x2v*)orow + 64 * j + lane) = w; }
}
__device__ __forceinline__ void row_phase(const float* base, const bf16* y, const float* ga, const float* gb, float* xout, bf16* hbuf, int gw, int NGW, int lane) {
    for (int m = gw; m < S; m += NGW) {
        f32x4 v[8], xb[8];
        load_row_bf16(y + (size_t)m * DM, lane, v); load_row(base + (size_t)m * DM, lane, xb);
        const float rs = 1.0f / sqrtf(sumsq_row(v) * (1.0f / DM) + EPS);
#pragma unroll
        for (int j = 0; j < 8; ++j) { const f32x4 gg = *((const f32x4*)ga + 64 * j + lane); xb[j] = xb[j] + v[j] * rs * gg; *((f32x4*)(xout + (size_t)m * DM) + 64 * j + lane) = xb[j]; }
        if (gb) norm_store_bf16(xb, gb, hbuf + (size_t)m * DM, lane);
    }
}

template <class Epi>
__device__ __forceinline__ void run_gemm(LAS unsigned char* lds, const bf16* A, const bf16* Bt, int N, int K, const Epi& E) {
    pg8::Gemm g{A, Bt, S, N, K}; pg8::StaticOrder So; So.init(S, N, (int)gridDim.x, (int)blockIdx.x);
    pg8::gemm_phase<Epi, pg8::StaticOrder, true, true>(lds, g, So, E);
}

__global__ void __launch_bounds__(NTHREADS) fwd_mega(Params P) {
    extern __shared__ __attribute__((aligned(16))) unsigned char lds_raw[];
    LAS unsigned char* lds = (LAS unsigned char*)lds_raw;
    cg::grid_group grid = cg::this_grid();
    const int tid = threadIdx.x, lane = tid & 63, wave = __builtin_amdgcn_readfirstlane(tid >> 6);
    const int G = gridDim.x; const int bx = blockIdx.x; const int vcu = (G % 8 == 0) ? (bx % 8) * (G / 8) + bx / 8 : bx;
    const int gw = vcu * NWAVES + wave, NGW = G * NWAVES;
    unsigned char* ws = P.ws;
    bf16* Wqkv = (bf16*)(ws + W_QKV); bf16* Wdo = (bf16*)(ws + W_DO); bf16* Wdown = (bf16*)(ws + W_DOWN); bf16* Wuq = (bf16*)(ws + W_UQ); bf16* Wukv = (bf16*)(ws + W_UKV);
    bf16* Wmo = (bf16*)(ws + W_MO); bf16* Wfin = (bf16*)(ws + W_FIN); bf16* Wfout = (bf16*)(ws + W_FOUT);
    bf16* HB = (bf16*)(ws + WS_H); bf16* CB = (bf16*)(ws + WS_C); float* YB = (float*)(ws + WS_E); bf16* YH = (bf16*)(ws + WS_E);
    bf16* CQN = (bf16*)(ws + WS_CQN); bf16* CKVN = (bf16*)(ws + WS_CKVN); bf16* KROPE = (bf16*)(ws + WS_KROPE); float* CS = (float*)(ws + WS_CS); float* POSF = (float*)(ws + WS_POSF);
    volatile LAS unsigned* bst = (volatile LAS unsigned*)(lds + LDS_BYTES - 64);
    if (tid < 2) bst[tid] = 0u;
    __syncthreads();
    XcdBarrier xbar = xcd_barrier_post((unsigned*)(ws + WS_BAR), bst);
    const int lo = P.ph_lo, hi_ph = P.ph_hi;
#define IN(k) (lo <= (k) && (k) < hi_ph)
#define SEAM(k) do { if (IN(k) && IN((k) + 1)) xcd_barrier(xbar); } while (0)
    if (lo < 0) grid.sync();

    if (IN(0)) {
        LAS float* scr = (LAS float*)(lds + wave * 16384);
        constexpr int I_QKV = (2048 / 64) * (6144 / 32), I_DO = (2048 / 64) * (2048 / 32), I_DOWN = (2048 / 64) * (1088 / 32), I_UQ = (512 / 64) * (3072 / 32), I_UKV = (512 / 64) * (4096 / 32),
                      I_MO = I_DO, I_FIN = (2048 / 64) * (11264 / 32), I_FOUT = (5632 / 64) * (2048 / 32);
        constexpr int NITEMS = I_QKV + I_DO + I_DOWN + I_UQ + I_UKV + I_MO + 2 * I_FIN + 2 * I_FOUT;
        auto decode = [&](int it) -> CvtItem {
            int r = it;
            if (r < I_QKV) return CvtItem{P.d_wqkv, Wqkv, 2048, 6144, 0, r}; r -= I_QKV;
            if (r < I_DO) return CvtItem{P.d_wo, Wdo, 2048, 2048, 0, r}; r -= I_DO;
            if (r < I_DOWN) return CvtItem{P.m_wdown, Wdown, 2048, 1088, 0, r}; r -= I_DOWN;
            if (r < I_UQ) return CvtItem{P.m_wuq, Wuq, 512, 3072, 2, r}; r -= I_UQ;
            if (r < I_UKV) return CvtItem{P.m_wukv, Wukv, 512, 4096, 0, r}; r -= I_UKV;
            if (r < I_MO) return CvtItem{P.m_wo, Wmo, 2048, 2048, 0, r}; r -= I_MO;
            if (r < 2 * I_FIN) { const int l = r / I_FIN; return CvtItem{P.f_win + (size_t)l * 2048 * 11264, Wfin + (size_t)l * 11264 * 2048, 2048, 11264, 1, r % I_FIN}; } r -= 2 * I_FIN;
            { const int l = r / I_FOUT; return CvtItem{P.f_wout + (size_t)l * 5632 * 2048, Wfout + (size_t)l * 2048 * 5632, 5632, 2048, 0, r % I_FOUT}; }
        };
        if (gw < NITEMS) {
            f32x4 wa[8], wb[8];
            CvtItem cur = decode(gw); cvt_load(cur, lane, wa);
            for (int it = gw;;) {
                const int nx = it + NGW; const bool hn = nx < NITEMS;
                CvtItem nxt = cur;
                if (hn) { nxt = decode(nx); cvt_load(nxt, lane, wb); }
                cvt_finish(cur, lane, wa, scr);
                if (!hn) break;
#pragma unroll
                for (int i = 0; i < 8; ++i) wa[i] = wb[i];
                cur = nxt; it = nx;
            }
        }
        if (bx == 0 && tid == 0) *(unsigned*)(ws + WS_CTR) = 0u;
        for (int i = bx * NTHREADS + tid; i < (1280 - 1088) * 2048 / 8; i += G * NTHREADS) *((u32x4v*)(Wdown + (size_t)1088 * 2048) + i) = (u32x4v){0u, 0u, 0u, 0u};
        for (int i = bx * NTHREADS + tid; i < S; i += G * NTHREADS) { const float pf = (float)P.pos[i]; POSF[i] = pf;
#pragma unroll
            for (int h = 0; h < 8; ++h) POSF[(h + 1) * S + i] = pf * (11.313708498984761f * __builtin_amdgcn_exp2f(-(float)(h + 1))); }
        for (int m = gw; m < S; m += NGW) { f32x4 v[8]; load_row(P.x + (size_t)m * DM, lane, v); norm_store_bf16(v, P.gains, HB + (size_t)m * DM, lane); }
    }
    SEAM(0);
    if (IN(1)) { pg8::EpiQKV E{CB, CB + (size_t)16 * S * 128, CB + (size_t)32 * S * 128, S}; run_gemm(lds, HB, Wqkv, 6144, 2048, E);
        xcd_barrier(xbar);
        float* KMAXT = (float*)(ws + WS_KMAXT); float* PMAXT = (float*)(ws + WS_PMAXT); float* PMINT = (float*)(ws + WS_PMINT);
        const bf16* Kh = CB + (size_t)16 * S * 128;
        for (int task = gw; task < 16 * 256; task += NGW) {
            const u32x4v* kr = (const u32x4v*)(Kh + ((size_t)(task >> 8) * S + (size_t)(task & 255) * 64 + lane) * 128);
            float ssq = 0.f;
#pragma unroll
            for (int i = 0; i < 16; ++i) { const u32x4v w = kr[i];
#pragma unroll
                for (int j = 0; j < 4; ++j) { const float a = __uint_as_float(w[j] << 16), b = __uint_as_float(w[j] & 0xffff0000u); ssq += a * a + b * b; } }
#pragma unroll
            for (int o = 1; o < 64; o <<= 1) ssq = __builtin_fmaxf(ssq, __shfl_xor(ssq, o));
            if (lane == 0) KMAXT[task] = sqrtf(ssq) * 1.002f;
        }
        for (int task = gw; task < 8 * 256; task += NGW) {
            const float v = POSF[(size_t)((task >> 8) + 1) * S + (task & 255) * 64 + lane];
            float mx = v, mn = v;
#pragma unroll
            for (int o = 1; o < 64; o <<= 1) { mx = __builtin_fmaxf(mx, __shfl_xor(mx, o)); mn = __builtin_fminf(mn, __shfl_xor(mn, o)); }
            if (lane == 0) { PMAXT[task] = mx; PMINT[task] = mn; }
        }
    }
    SEAM(1);
    if (IN(2)) {
        _Float16* OX = (_Float16*)(ws + WS_E);
        const int r32 = lane & 31, hi = lane >> 5, pw = wave & 3, dvo = (wave >> 2) * 128;
        {
            unsigned* ctr = (unsigned*)(ws + WS_CTR);
            volatile LAS unsigned* ub = (volatile LAS unsigned*)(lds + att::PR_X + 2048);
            const float* KMAXT = (const float*)(ws + WS_KMAXT); const float* PMAXT = (const float*)(ws + WS_PMAXT); const float* PMINT = (const float*)(ws + WS_PMINT);
            for (;;) {
                if (tid == 0) *ub = atomicAdd(ctr, 1u);
                __syncthreads();
                const unsigned u = *ub;
                __syncthreads();
                if (u >= 2048u) break;
                const int head = 7 - (int)(u >> 8), qb = 127 - (int)((u & 255u) >> 1), sm = (int)(u & 1u), q0 = qb * 128;
                const int qidx = q0 + 32 * pw + r32;
                att::Args A; A.Q = CB + (size_t)(head * 2 + sm) * S * 128; A.qpitch = 128; A.K = CB + (size_t)16 * S * 128 + (size_t)(head * 2 + sm) * S * 128; A.kpitch = 128; A.K2 = nullptr; A.k2pitch = 0;
                A.V = CB + (size_t)32 * S * 128 + (size_t)head * S * 256; A.vpitch = 256; A.posf = POSF + (size_t)(head + 1) * S; A.c1 = 0.08838834764831845f * 1.4426950408889634f; A.slope2 = 0.f;
                A.kmaxt = KMAXT + (head * 2 + sm) * 256; A.pmaxt = PMAXT + head * 256; A.pmint = PMINT + head * 256;
                att::f32x16 o[4];
                const float inv = att::attn_diff_pair(lds, A, q0, o);
                _Float16* orow = OX + (size_t)sm * S * DM + (size_t)qidx * DM + head * 256 + dvo + 4 * hi;
#pragma unroll
                for (int db = 0; db < 4; ++db)
#pragma unroll
                    for (int g = 0; g < 4; ++g) {
                        typedef _Float16 h4 __attribute__((ext_vector_type(4)));
                        h4 w; w[0] = (_Float16)(o[db][4 * g] * inv); w[1] = (_Float16)(o[db][4 * g + 1] * inv); w[2] = (_Float16)(o[db][4 * g + 2] * inv); w[3] = (_Float16)(o[db][4 * g + 3] * inv);
                        *(h4*)(orow + 32 * db + 8 * g) = w; }
            }
        }
        xcd_barrier(xbar);
        {
            float lam_full;
            { const float* L = P.d_lam; const float a = L[lane] * L[128 + lane] + L[64 + lane] * L[192 + lane], b = L[256 + lane] * L[384 + lane] + L[320 + lane] * L[448 + lane];
              lam_full = __expf(wave_sum(a)) - __expf(wave_sum(b)) + 0.2f; }
            typedef _Float16 h4 __attribute__((ext_vector_type(4)));
            const f32x4 gg = *((const f32x4*)P.d_subln + lane);
            for (int it = gw; it < S * 8; it += NGW) {
                const size_t off = (size_t)it * 256 + lane * 4;
                const h4 a = *(const h4*)(OX + off), b = *(const h4*)(OX + (size_t)S * DM + off);
                f32x4 v; v.x = (float)a[0] - lam_full * (float)b[0]; v.y = (float)a[1] - lam_full * (float)b[1]; v.z = (float)a[2] - lam_full * (float)b[2]; v.w = (float)a[3] - lam_full * (float)b[3];
                const float ss = wave_sum((v.x * v.x + v.y * v.y) + (v.z * v.z + v.w * v.w));
                const float rs = 0.8f / sqrtf(ss * (1.0f / 256.0f) + EPS);
                u32x2v w; w.x = pk2(v.x * rs * gg.x, v.y * rs * gg.y); w.y = pk2(v.z * rs * gg.z, v.w * rs * gg.w);
                *(u32x2v*)(HB + off) = w;
            }
        }
    }
    SEAM(2);
    if (IN(3)) { pg8::EpiBf16 E{YH, DM}; run_gemm(lds, HB, Wdo, 2048, 2048, E); }
    SEAM(3);
    if (IN(4)) row_phase(P.x, YH, P.gains + 1 * DM, P.gains + 2 * DM, P.out, HB, gw, NGW, lane);
    SEAM(4);
    if (IN(5)) { pg8::EpiSwiGLU E{CB, FF}; run_gemm(lds, HB, Wfin, 11264, 2048, E); }
    SEAM(5);
    if (IN(6)) { pg8::EpiBf16 E{YH, DM}; run_gemm(lds, CB, Wfout, 2048, FF, E); }
    SEAM(6);
    if (IN(7)) row_phase(P.out, YH, P.gains + 3 * DM, P.gains + 4 * DM, P.out, HB, gw, NGW, lane);
    SEAM(7);
    if (IN(8)) { pg8::EpiF32 E{YB, 1280}; run_gemm(lds, HB, Wdown, 1280, 2048, E); }
    SEAM(8);
    if (IN(9)) {
        for (int m = gw; m < S; m += NGW) {
            const float* c = YB + (size_t)m * 1280;
#pragma unroll
            for (int part = 0; part < 2; ++part) {
                const f32x4 a = *((const f32x4*)(c + part * 512) + lane), b = *((const f32x4*)(c + part * 512) + 64 + lane);
                const float ss = wave_sum((a.x * a.x + a.y * a.y) + (a.z * a.z + a.w * a.w) + (b.x * b.x + b.y * b.y) + (b.z * b.z + b.w * b.w));
                const float rs = 1.0f / sqrtf(ss * (1.0f / 512.0f) + EPS);
                const float* gn = part == 0 ? P.m_qn : P.m_kvn; bf16* dst = (part == 0 ? CQN : CKVN) + (size_t)m * 512;
                const f32x4 ga = *((const f32x4*)gn + lane), gb = *((const f32x4*)gn + 64 + lane);
                u32x2v w; w.x = pk2(a.x * rs * ga.x, a.y * rs * ga.y); w.y = pk2(a.z * rs * ga.z, a.w * rs * ga.w); *((u32x2v*)dst + lane) = w;
                w.x = pk2(b.x * rs * gb.x, b.y * rs * gb.y); w.y = pk2(b.z * rs * gb.z, b.w * rs * gb.w); *((u32x2v*)dst + 64 + lane) = w;
            }
            if (lane < 32) {
                const float ang = POSF[m] * P.inv_freq[lane];
                const float cc = cosf(ang), sn = sinf(ang);
                const float x1 = c[1024 + lane], x2 = c[1056 + lane];
                KROPE[(size_t)m * 64 + lane] = (bf16)f2bf(x1 * cc - x2 * sn); KROPE[(size_t)m * 64 + 32 + lane] = (bf16)f2bf(x2 * cc + x1 * sn);
                CS[(size_t)m * 64 + lane] = cc; CS[(size_t)m * 64 + 32 + lane] = sn;
            }
        }
    }
    SEAM(9);
    bf16* QB2 = CB; bf16* KVB = CB + (size_t)S * 3072;
    if (IN(10)) {
        { pg8::EpiQRope E{QB2, CS}; run_gemm(lds, CQN, Wuq, 3072, 512, E); }
        { pg8::EpiBf16 E{KVB, 4096}; run_gemm(lds, CKVN, Wukv, 4096, 512, E); }
    }
    SEAM(10);
    if (IN(11)) {
        const int r32 = lane & 31, hi = lane >> 5;
        for (int pr = vcu; pr < 16 * 32; pr += G) {
            const int head = pr >> 5, sidx = pr & 31;
            for (int half = 0; half < 2; ++half) {
                const int qb = half == 0 ? 63 - sidx : sidx, q0 = qb * 256;
                const int qidx = q0 + 32 * wave + r32;
                att::Args A; A.Q = QB2 + head * 192; A.qpitch = 3072; A.K = KVB + head * 256; A.kpitch = 4096; A.K2 = KROPE; A.k2pitch = 64;
                A.V = KVB + head * 256 + 128; A.vpitch = 4096; A.posf = nullptr; A.c1 = 0.07216878364870323f * 1.4426950408889634f; A.slope2 = 0.f; A.kmaxt = nullptr; A.pmaxt = nullptr; A.pmint = nullptr;
                att::f32x16 o[4];
                const float inv = att::attn_mla_lag(lds, A, q0, o);
                bf16* orow = HB + (size_t)qidx * DM + head * 128 + 4 * hi;
#pragma unroll
                for (int db = 0; db < 4; ++db)
#pragma unroll
                    for (int g = 0; g < 4; ++g) { u32x2v w; w.x = pk2(o[db][4 * g] * inv, o[db][4 * g + 1] * inv); w.y = pk2(o[db][4 * g + 2] * inv, o[db][4 * g + 3] * inv);
                        *(u32x2v*)(orow + 32 * db + 8 * g) = w; }
            }
        }
    }
    SEAM(11);
    if (IN(12)) { pg8::EpiBf16 E{YH, DM}; run_gemm(lds, HB, Wmo, 2048, 2048, E); }
    SEAM(12);
    if (IN(13)) row_phase(P.out, YH, P.gains + 5 * DM, P.gains + 6 * DM, P.out, HB, gw, NGW, lane);
    SEAM(13);
    if (IN(14)) { pg8::EpiSwiGLU E{CB, FF}; run_gemm(lds, HB, Wfin + (size_t)11264 * 2048, 11264, 2048, E); }
    SEAM(14);
    if (IN(15)) { pg8::EpiBf16 E{YH, DM}; run_gemm(lds, CB, Wfout + (size_t)2048 * 5632, 2048, FF, E); }
    SEAM(15);
    if (IN(16)) row_phase(P.out, YH, P.gains + 7 * DM, nullptr, P.out, nullptr, gw, NGW, lane);
#undef IN
#undef SEAM
}

constexpr int N_PHASES = 17;
#ifndef MK_MULTI
#define MK_MULTI 0
#endif
extern "C" void kernel_launch(void* const* d_in, const int* in_sizes, int n_in, void* d_out, int out_size, void* d_ws, size_t ws_size, hipStream_t stream) {
    static int grid = 0;
    if (grid == 0) {
        if (n_in != 15 || in_sizes[0] != S * DM || out_size != S * DM || ws_size < WS_END) { fprintf(stderr, "kernel_launch: unexpected shapes / workspace (n_in %d, in0 %d, out %d, ws %zu < %zu)\n", n_in, n_in > 0 ? in_sizes[0] : -1, out_size, ws_size, (size_t)WS_END); grid = -1; return; }
        int dev = 0, cus = 0, per_cu = 0;
        hipGetDevice(&dev); hipDeviceGetAttribute(&cus, hipDeviceAttributeMultiprocessorCount, dev);
        if (hipFuncSetAttribute((const void*)fwd_mega, hipFuncAttributeMaxDynamicSharedMemorySize, LDS_BYTES) != hipSuccess) { fprintf(stderr, "kernel_launch: hipFuncSetAttribute failed\n"); grid = -1; return; }
        if (hipOccupancyMaxActiveBlocksPerMultiprocessor(&per_cu, (const void*)fwd_mega, NTHREADS, LDS_BYTES) != hipSuccess || per_cu < 1) { fprintf(stderr, "kernel_launch: occupancy query gave %d\n", per_cu); per_cu = 1; (void)hipGetLastError(); }
        grid = cus * 1;
    }
    if (grid < 0) return;
    if (hipMemsetAsync((char*)d_ws + WS_BAR, 0, XCD_BAR_WORDS * 4, stream) != hipSuccess) { fprintf(stderr, "kernel_launch: hipMemsetAsync of the barrier words failed\n"); return; }
    Params p; memset(&p, 0, sizeof(p));
    p.x = (const float*)d_in[0]; p.pos = (const int*)d_in[1]; p.gains = (const float*)d_in[2]; p.d_wqkv = (const float*)d_in[3]; p.d_lam = (const float*)d_in[4]; p.d_subln = (const float*)d_in[5];
    p.d_wo = (const float*)d_in[6]; p.m_wdown = (const float*)d_in[7]; p.m_qn = (const float*)d_in[8]; p.m_kvn = (const float*)d_in[9]; p.m_wuq = (const float*)d_in[10]; p.m_wukv = (const float*)d_in[11];
    p.m_wo = (const float*)d_in[12]; p.f_win = (const float*)d_in[13]; p.f_wout = (const float*)d_in[14]; p.out = (float*)d_out; p.ws = (unsigned char*)d_ws;
    for (int i = 0; i < 32; ++i) p.inv_freq[i] = (float)pow(10000.0, -(double)(2 * i) / 64.0);
#if MK_MULTI
    for (int ph = 0; ph < N_PHASES; ++ph) { p.ph_lo = ph; p.ph_hi = ph + 1; void* args[] = {&p};
        hipError_t e = hipLaunchCooperativeKernel((const void*)fwd_mega, dim3(grid), dim3(NTHREADS), args, LDS_BYTES, stream);
        if (e != hipSuccess) { fprintf(stderr, "cooperative launch failed: %s\n", hipGetErrorString(e)); return; } }
#else
    p.ph_lo = 0; p.ph_hi = N_PHASES; void* args[] = {&p};
    hipError_t e = hipLaunchCooperativeKernel((const void*)fwd_mega, dim3(grid), dim3(NTHREADS), args, LDS_BYTES, stream);
    if (e != hipSuccess) fprintf(stderr, "cooperative launch failed: %s (grid %d)\n", hipGetErrorString(e), grid);
#endif
}
```
